# Optimizing an MI355X kernel written in HIP

```python
import math
import jax, jax.numpy as jnp
from jax import lax
import numpy as np

D_MODEL = 1024
BATCH = 4
SEQ = 4096
DEPTH = 2

N_MEM = 256
N_MIXERS = 2
D_MIX = D_MODEL
ML_HEADS = 4
ML_HEAD_DIM = 192
ML_WIDTH = ML_HEADS * ML_HEAD_DIM
ML_CHUNK = 64
RG_WIDTH = 768
RG_BLOCKS = 8
RG_BLOCK_DIM = RG_WIDTH // RG_BLOCKS
RG_CONV = 4
RG_C = 8.0
XA_HEADS = 4
XA_HEAD_DIM = 64
XA_WIDTH = XA_HEADS * XA_HEAD_DIM
PEER_HEADS = 8
PEER_KEYS = 128
PEER_EXPERTS = PEER_KEYS * PEER_KEYS
PEER_HALF = 128
PEER_QDIM = 2 * PEER_HALF
PEER_TOPK = 16
PEER_TOK_BLOCK = 128
DN_ALPHA = (2 * DEPTH) ** 0.25
DN_BETA = (8 * DEPTH) ** -0.25
LN_EPS = 1e-5
N_A = (DEPTH + 1) // 2
N_B = DEPTH // 2
ML_IN = 4 * ML_WIDTH + 2 * ML_HEADS + XA_WIDTH
RG_IN = 2 * RG_WIDTH + XA_WIDTH

kernel_name = "hybrid_mlstm_rglru_peer_deepnorm"


def layer_norm(x, g, b):
    xf = x.astype(jnp.float32)
    mu = jnp.mean(xf, axis=-1, keepdims=True)
    var = jnp.mean(jnp.square(xf - mu), axis=-1, keepdims=True)
    y = (xf - mu) * lax.rsqrt(var + LN_EPS) * g.astype(jnp.float32) + b.astype(jnp.float32)
    return y.astype(x.dtype)


def cross_attention(xq, mem, w_kv):
    B, S, _ = xq.shape
    M = mem.shape[1]
    q = xq.reshape(B, S, XA_HEADS, XA_HEAD_DIM).astype(jnp.float32)
    kv = (mem @ w_kv).astype(jnp.float32)
    k = kv[..., :XA_WIDTH].reshape(B, M, XA_HEADS, XA_HEAD_DIM)
    v = kv[..., XA_WIDTH:].reshape(B, M, XA_HEADS, XA_HEAD_DIM)
    s = jnp.einsum('bshd,bmhd->bhsm', q, k) * (XA_HEAD_DIM ** -0.5)
    p = jax.nn.softmax(s, axis=-1)
    o = jnp.einsum('bhsm,bmhd->bshd', p, v)
    return o.reshape(B, S, XA_WIDTH).astype(xq.dtype)


def mlstm_mixer(zm, b_gates, norm_g):
    B, S, _ = zm.shape
    H, dh, L = ML_HEADS, ML_HEAD_DIM, ML_CHUNK
    nc = S // L
    W = ML_WIDTH
    q, k, v, o, g = jnp.split(zm, [W, 2 * W, 3 * W, 4 * W], axis=-1)
    g = g.astype(jnp.float32) + b_gates.astype(jnp.float32)
    ig = g[..., :H]
    lf = jax.nn.log_sigmoid(g[..., H:])

    def to_chunks(t):
        return t.astype(jnp.float32).reshape(B, nc, L, H, dh).transpose(1, 0, 3, 2, 4)

    def gate_chunks(t):
        return t.reshape(B, nc, L, H).transpose(1, 0, 3, 2)

    qc = to_chunks(q)
    kc = to_chunks(k) * (dh ** -0.5)
    vc = to_chunks(v)
    causal = jnp.tril(jnp.ones((L, L), dtype=bool))

    def step(carry, inp):
        C, n, m = carry
        qq, kk, vv, ii, ff = inp
        b = jnp.cumsum(ff, axis=-1)
        dmat = b[..., :, None] - b[..., None, :] + ii[..., None, :]
        dmat = jnp.where(causal, dmat, -jnp.inf)
        inter = b + m[..., None]
        mj = jnp.maximum(jnp.max(dmat, axis=-1), inter)
        w = jnp.exp(dmat - mj[..., None])
        s = jnp.einsum('bhld,bhsd->bhls', qq, kk) * w
        sc = jnp.exp(inter - mj)
        num = sc[..., None] * jnp.einsum('bhld,bhde->bhle', qq, C) + jnp.einsum('bhls,bhse->bhle', s, vv)
        den = sc * jnp.einsum('bhld,bhd->bhl', qq, n) + jnp.sum(s, axis=-1)
        h = num / jnp.maximum(jnp.abs(den), jnp.exp(-mj))[..., None]
        bl = b[..., -1]
        gl = bl[..., None] - b + ii
        m_new = jnp.maximum(bl + m, jnp.max(gl, axis=-1))
        wg = jnp.exp(gl - m_new[..., None])
        decay = jnp.exp(bl + m - m_new)
        C_new = decay[..., None, None] * C + jnp.einsum('bhl,bhld,bhle->bhde', wg, kk, vv)
        n_new = decay[..., None] * n + jnp.einsum('bhl,bhld->bhd', wg, kk)
        return (C_new, n_new, m_new), h

    init = (jnp.zeros((B, H, dh, dh), jnp.float32), jnp.zeros((B, H, dh), jnp.float32),
            jnp.zeros((B, H), jnp.float32))
    _, hc = lax.scan(step, init, (qc, kc, vc, gate_chunks(ig), gate_chunks(lf)))
    h = hc.transpose(1, 0, 3, 2, 4).reshape(B, S, H, dh)
    mu = jnp.mean(h, axis=-1, keepdims=True)
    var = jnp.mean(jnp.square(h - mu), axis=-1, keepdims=True)
    hn = (h - mu) * lax.rsqrt(var + LN_EPS) * norm_g.astype(jnp.float32).reshape(H, dh)
    y = hn.reshape(B, S, W) * jax.nn.sigmoid(o.astype(jnp.float32))
    return y.astype(zm.dtype)


def rglru_mixer(zr, conv_w, conv_b, w_a, b_a, w_x, b_x, lam):
    B, S, _ = zr.shape
    gate = zr[..., :RG_WIDTH]
    xr = zr[..., RG_WIDTH:]
    xr = lax.conv_general_dilated(xr, conv_w[:, None, :], window_strides=(1,),
                                  padding=[(RG_CONV - 1, 0)],
                                  dimension_numbers=('NWC', 'WIO', 'NWC'),
                                  feature_group_count=RG_WIDTH) + conv_b
    xb = xr.reshape(B, S, RG_BLOCKS, RG_BLOCK_DIM)
    r = jax.nn.sigmoid((jnp.einsum('bsgi,gij->bsgj', xb, w_a).reshape(B, S, RG_WIDTH) + b_a).astype(jnp.float32))
    i = jax.nn.sigmoid((jnp.einsum('bsgi,gij->bsgj', xb, w_x).reshape(B, S, RG_WIDTH) + b_x).astype(jnp.float32))
    log_a = -RG_C * r * jax.nn.softplus(-lam.astype(jnp.float32))
    a = jnp.exp(log_a)
    u = jnp.sqrt(-jnp.expm1(2.0 * log_a)) * (i * xr.astype(jnp.float32))

    def combine(e1, e2):
        a1, b1 = e1
        a2, b2 = e2
        return a1 * a2, a2 * b1 + b2

    _, h = lax.associative_scan(combine, (a, u), axis=1)
    y = h * jax.nn.gelu(gate.astype(jnp.float32), approximate=False)
    return y.astype(zr.dtype)


def peer_ffn(x, w_q, subkeys, u_tab, v_tab):
    B, S, D = x.shape
    n = PEER_TOK_BLOCK
    xt = x.reshape((B * S) // n, n, D)
    sk = subkeys.astype(jnp.float32)

    def block(xb):
        q = (xb @ w_q).reshape(n, PEER_HEADS, 2, PEER_HALF).astype(jnp.float32)
        s = jnp.einsum('nhpc,pkc->nhpk', q, sk)
        sv, si = lax.top_k(s, PEER_TOPK)
        cand = sv[:, :, 0, :, None] + sv[:, :, 1, None, :]
        cand_id = si[:, :, 0, :, None] * PEER_KEYS + si[:, :, 1, None, :]
        fv, fi = lax.top_k(cand.reshape(n, PEER_HEADS, PEER_TOPK * PEER_TOPK), PEER_TOPK)
        eid = jnp.take_along_axis(cand_id.reshape(n, PEER_HEADS, PEER_TOPK * PEER_TOPK), fi, axis=-1)
        gw = jax.nn.softmax(fv, axis=-1)
        u = u_tab[eid]
        act = jax.nn.gelu(jnp.einsum('nhkd,nd->nhk', u, xb).astype(jnp.float32), approximate=False)
        coef = (gw * act).astype(x.dtype)
        return jnp.einsum('nhk,nhkd->nd', coef, v_tab[eid])

    y = lax.map(block, xt)
    return y.reshape(B, S, D)


def setup_inputs(seed: int = 0) -> dict:
    key = jax.random.key(seed)
    ks = jax.random.split(key, 24)
    D = D_MODEL
    nrm = jax.random.normal
    x = nrm(ks[0], (BATCH, SEQ, D), jnp.float32)
    mem = nrm(ks[1], (BATCH, N_MEM, D), jnp.float32)
    mlstm_w_in = nrm(ks[2], (N_A, D, ML_IN), jnp.float32) * D ** -0.5
    f_bias = jnp.linspace(3.0, 6.0, ML_HEADS, dtype=jnp.float32)
    mlstm_b_gates = jnp.concatenate([
        0.1 * nrm(ks[3], (N_A, ML_HEADS), jnp.float32),
        f_bias[None, :] + 0.1 * nrm(ks[4], (N_A, ML_HEADS), jnp.float32)], axis=-1)
    mlstm_norm_g = 1.0 + 0.02 * nrm(ks[5], (N_A, ML_WIDTH), jnp.float32)
    rglru_w_in = nrm(ks[6], (N_B, D, RG_IN), jnp.float32) * D ** -0.5
    rglru_conv_w = nrm(ks[7], (N_B, RG_CONV, RG_WIDTH), jnp.float32) * RG_CONV ** -0.5
    rglru_conv_b = 0.01 * nrm(ks[8], (N_B, RG_WIDTH), jnp.float32)
    rglru_w_a = nrm(ks[9], (N_B, RG_BLOCKS, RG_BLOCK_DIM, RG_BLOCK_DIM), jnp.float32) * RG_BLOCK_DIM ** -0.5
    rglru_b_a = 0.01 * nrm(ks[10], (N_B, RG_WIDTH), jnp.float32)
    rglru_w_x = nrm(ks[11], (N_B, RG_BLOCKS, RG_BLOCK_DIM, RG_BLOCK_DIM), jnp.float32) * RG_BLOCK_DIM ** -0.5
    rglru_b_x = 0.01 * nrm(ks[12], (N_B, RG_WIDTH), jnp.float32)
    a0 = jax.random.uniform(ks[13], (N_B, RG_WIDTH), jnp.float32, 0.9, 0.999)
    p = a0 ** (1.0 / RG_C)
    rglru_lam = jnp.log(p) - jnp.log1p(-p)
    xattn_w_kv = nrm(ks[14], (DEPTH, D, 2 * XA_WIDTH), jnp.float32) * D ** -0.5
    w_out = nrm(ks[15], (DEPTH, D_MIX, D), jnp.float32) * (D_MIX ** -0.5) * DN_BETA
    ln1_g = 1.0 + 0.02 * nrm(ks[16], (DEPTH, D), jnp.float32)
    ln1_b = 0.01 * nrm(ks[17], (DEPTH, D), jnp.float32)
    peer_w_q = nrm(ks[18], (DEPTH, D, PEER_HEADS * PEER_QDIM), jnp.float32) * D ** -0.5
    peer_subkeys = nrm(ks[19], (DEPTH, 2, PEER_KEYS, PEER_HALF), jnp.float32) * PEER_HALF ** -0.5
    peer_u = nrm(ks[20], (DEPTH, PEER_EXPERTS, D), jnp.float32) * D ** -0.5
    peer_v = nrm(ks[21], (DEPTH, PEER_EXPERTS, D), jnp.float32) * (D ** -0.5) * DN_BETA
    ln2_g = 1.0 + 0.02 * nrm(ks[22], (DEPTH, D), jnp.float32)
    ln2_b = 0.01 * nrm(ks[23], (DEPTH, D), jnp.float32)
    return {"x": x, "mem": mem,
            "mlstm_w_in": mlstm_w_in, "mlstm_b_gates": mlstm_b_gates, "mlstm_norm_g": mlstm_norm_g,
            "rglru_w_in": rglru_w_in, "rglru_conv_w": rglru_conv_w, "rglru_conv_b": rglru_conv_b,
            "rglru_w_a": rglru_w_a, "rglru_b_a": rglru_b_a, "rglru_w_x": rglru_w_x, "rglru_b_x": rglru_b_x,
            "rglru_lam": rglru_lam, "xattn_w_kv": xattn_w_kv, "w_out": w_out,
            "ln1_g": ln1_g, "ln1_b": ln1_b, "peer_w_q": peer_w_q, "peer_subkeys": peer_subkeys,
            "peer_u": peer_u, "peer_v": peer_v, "ln2_g": ln2_g, "ln2_b": ln2_b}


def reference(x, mem, mlstm_w_in, mlstm_b_gates, mlstm_norm_g, rglru_w_in, rglru_conv_w, rglru_conv_b,
              rglru_w_a, rglru_b_a, rglru_w_x, rglru_b_x, rglru_lam, xattn_w_kv, w_out,
              ln1_g, ln1_b, peer_w_q, peer_subkeys, peer_u, peer_v, ln2_g, ln2_b):
    for i in range(DEPTH):
        j = i // N_MIXERS
        if i % N_MIXERS == 0:
            z = x @ mlstm_w_in[j]
            hm = mlstm_mixer(z[..., :ML_IN - XA_WIDTH], mlstm_b_gates[j], mlstm_norm_g[j])
            xq = z[..., ML_IN - XA_WIDTH:]
        else:
            z = x @ rglru_w_in[j]
            hm = rglru_mixer(z[..., :RG_IN - XA_WIDTH], rglru_conv_w[j], rglru_conv_b[j],
                             rglru_w_a[j], rglru_b_a[j], rglru_w_x[j], rglru_b_x[j], rglru_lam[j])
            xq = z[..., RG_IN - XA_WIDTH:]
        ha = cross_attention(xq, mem, xattn_w_kv[i])
        mix = jnp.concatenate([hm, ha], axis=-1) @ w_out[i]
        x = layer_norm(DN_ALPHA * x + mix, ln1_g[i], ln1_b[i])
        y = peer_ffn(x, peer_w_q[i], peer_subkeys[i], peer_u[i], peer_v[i])
        x = layer_norm(DN_ALPHA * x + y, ln2_g[i], ln2_b[i])
    return x
```

```cpp
#include <hip/hip_runtime.h>
#include <hip/hip_cooperative_groups.h>
#include <cstdio>
#include <cstdint>
namespace cg = cooperative_groups;

#ifndef MK_COOP
#define MK_COOP 1
#endif

#define LAS __attribute__((address_space(3)))
typedef unsigned short u16;
typedef unsigned int u32x4 __attribute__((ext_vector_type(4)));
__device__ __forceinline__ int tidx_() { int t = threadIdx.x; asm volatile("" : "+v"(t)); return t; }
typedef float f32x4v __attribute__((ext_vector_type(4)));
typedef __attribute__((ext_vector_type(8))) short bf16x8;
typedef __attribute__((ext_vector_type(16))) float f32x16;

constexpr int T_TOK = 16384, DM = 1024, SEQ = 4096;
constexpr int ZLD0 = 3328, ZLD1 = 1792;
constexpr float DN_ALPHA = 1.41421356237f;
constexpr float LN_EPS = 1e-5f;
constexpr size_t MiB = 1024 * 1024;

constexpr size_t OFF_TAB  = 0;
constexpr size_t OFF_Z    = 128 * MiB;
constexpr size_t OFF_SCR  = 232 * MiB;
constexpr size_t OFF_XB   = 376 * MiB;
constexpr size_t OFF_CAT  = 408 * MiB;
constexpr size_t OFF_TK   = 440 * MiB;
constexpr size_t OFF_SEL  = 456 * MiB;
constexpr size_t OFF_W    = 472 * MiB;
constexpr size_t OFF_MISC = 500 * MiB;
constexpr size_t WS_NEED  = 508 * MiB;
constexpr size_t W_IN0  = OFF_W;
constexpr size_t W_IN1  = W_IN0 + 7 * MiB;
constexpr size_t W_OUT  = W_IN1 + 4 * MiB;
constexpr size_t W_Q    = W_OUT + 4 * MiB;
constexpr size_t W_KV   = W_Q + 8 * MiB;
constexpr size_t W_MEM  = W_KV + 2 * MiB;
constexpr size_t W_SK   = W_MEM + 2 * MiB;
constexpr size_t W_AF   = W_SK + 128 * 1024;
constexpr size_t M_GATES = OFF_MISC;
constexpr size_t M_STBL  = M_GATES + 512 * 1024;
constexpr size_t M_STML  = M_STBL + 4096;
constexpr size_t M_MIN   = M_STML + 4096;
constexpr size_t M_NLOC  = M_MIN + 4096;
constexpr size_t M_NIN   = M_NLOC + 768 * 1024;
constexpr size_t M_KF    = M_NIN + 768 * 1024;
constexpr size_t M_VF    = M_KF + 1024 * 1024;
constexpr size_t M_SUMP  = M_VF + 1024 * 1024;
constexpr size_t M_SUMH  = M_SUMP + 1536 * 1024;
constexpr size_t M_BAR   = M_SUMH + 1536 * 1024;
constexpr size_t M_TSC   = M_BAR + 16 * 1024;

struct Params {
  const float* in[23];
  float* out;
  unsigned char* ws;
  int ph_lo, ph_hi;
};

constexpr int SMEM_BYTES = 79872;
constexpr int BKP = 72;

typedef float f2cv_ __attribute__((ext_vector_type(2)));
typedef __bf16 bf2cv_ __attribute__((ext_vector_type(2)));
__device__ __forceinline__ u16 f2bf(float f) { __bf16 s = (__bf16)f; return __builtin_bit_cast(u16, s); }
__device__ __forceinline__ float bf2f(u16 h) { return __uint_as_float(((unsigned)h) << 16); }
__device__ __forceinline__ unsigned pack2(float a, float b) { f2cv_ v; v.x = a; v.y = b; bf2cv_ r = __builtin_convertvector(v, bf2cv_); return __builtin_bit_cast(unsigned, r); }
__device__ __forceinline__ float bflo(unsigned w) { return __uint_as_float(w << 16); }
__device__ __forceinline__ float bfhi(unsigned w) { return __uint_as_float(w & 0xffff0000u); }
__device__ __forceinline__ float sigmoidf_(float x) { return 1.f / (1.f + __expf(-x)); }
__device__ __forceinline__ float logsigmoidf_(float x) { return fminf(x, 0.f) - log1pf(expf(-fabsf(x))); }
__device__ __forceinline__ float softplusf_(float x) { return fmaxf(x, 0.f) + log1pf(expf(-fabsf(x))); }
__device__ __forceinline__ float erf_as_(float x) {
  const float ax = fabsf(x);
  const float t = __builtin_amdgcn_rcpf(1.f + 0.3275911f * ax);
  const float poly = t * (0.254829592f + t * (-0.284496736f + t * (1.421413741f + t * (-1.453152027f + t * 1.061405429f))));
  const float r = 1.f - poly * __expf(-ax * ax);
  return copysignf(r, x);
}
__device__ __forceinline__ float geluf_(float x) { return 0.5f * x * (1.f + erf_as_(x * 0.70710678118654752f)); }
__device__ __forceinline__ float wsum(float v) {
#pragma unroll
  for (int o = 32; o > 0; o >>= 1) v += __shfl_xor(v, o);
  return v;
}
__device__ __forceinline__ float wmax(float v) {
#pragma unroll
  for (int o = 32; o > 0; o >>= 1) v = fmaxf(v, __shfl_xor(v, o));
  return v;
}
__device__ __forceinline__ int crow(int reg, int h) { return (reg & 3) + 8 * (reg >> 2) + 4 * h; }
__device__ __forceinline__ f32x16 zero16() {
  f32x16 z;
#pragma unroll
  for (int i = 0; i < 16; ++i) z[i] = 0.f;
  return z;
}
__device__ __forceinline__ bf16x8 ldsfrag(const u16* p) { return *reinterpret_cast<const bf16x8*>(p); }
__device__ __forceinline__ bf16x8 gfrag(const u16* p) { return *reinterpret_cast<const bf16x8*>(p); }
__device__ __forceinline__ bf16x8 ldsfrag_strided(const u16* p, int stride) {
  bf16x8 f;
#pragma unroll
  for (int j = 0; j < 8; ++j) f[j] = (short)p[j * stride];
  return f;
}
__device__ __forceinline__ void ins16(float (&s)[16], float x) {
#pragma unroll
  for (int i = 15; i >= 1; --i) s[i] = __builtin_amdgcn_fmed3f(s[i - 1], s[i], x);
  s[0] = __builtin_amdgcn_fmed3f(__builtin_inff(), s[0], x);
}

__device__ __forceinline__ void gemm_mainloop(const u16* __restrict__ A, const u16* __restrict__ Bt, int m0, int n0,
                                              u16* lds, f32x16 (&acc)[4][2]) {
  const int tid = tidx_(), lane = tid & 63, w = tid >> 6, wm = w >> 1, wn = w & 1, r = lane & 31, h = lane >> 5;
#pragma unroll
  for (int i = 0; i < 4; ++i)
#pragma unroll
    for (int j = 0; j < 2; ++j) acc[i][j] = zero16();
  unsigned char* ldsb = (unsigned char*)lds;
  const int skc = (lane & 3) ^ ((lane >> 4) & 3);
  const u16* Ag = A + (size_t)(m0 + w * 16 + (lane >> 2)) * 1024 + skc * 8;
  const u16* Bg = Bt + (size_t)(n0 + w * 16 + (lane >> 2)) * 1024 + skc * 8;
  const int sw = (r >> 2) & 3;
  const int aoff = (wm * 128 + r) * 64;
  const int boff = 16384 + (wn * 64 + r) * 64;
#define GLDS_STAGE(BUF, KT) do { \
    _Pragma("unroll") \
    for (int i_ = 0; i_ < 4; ++i_) \
      __builtin_amdgcn_global_load_lds((const unsigned*)(Ag + (size_t)i_ * 64 * 1024 + (KT) * 32), (LAS unsigned*)(ldsb + (BUF) * 24576 + (i_ * 4 + w) * 1024), 16, 0, 0); \
    _Pragma("unroll") \
    for (int i_ = 0; i_ < 2; ++i_) \
      __builtin_amdgcn_global_load_lds((const unsigned*)(Bg + (size_t)i_ * 64 * 1024 + (KT) * 32), (LAS unsigned*)(ldsb + (BUF) * 24576 + 16384 + (i_ * 4 + w) * 1024), 16, 0, 0); \
    } while (0)
#define KSTEP(KT, CUR, NXT2, ISSUE) do { \
    if (ISSUE) GLDS_STAGE(NXT2, (KT) + 2); \
    const unsigned char* Bf_ = ldsb + (CUR) * 24576; \
    _Pragma("unroll") \
    for (int kk = 0; kk < 2; ++kk) { \
      const int c_ = ((kk * 2 + h) ^ sw) << 4; \
      bf16x8 b0 = *reinterpret_cast<const bf16x8*>(Bf_ + boff + c_); \
      bf16x8 b1 = *reinterpret_cast<const bf16x8*>(Bf_ + boff + 2048 + c_); \
      _Pragma("unroll") \
      for (int i_ = 0; i_ < 4; ++i_) { \
        bf16x8 a_ = *reinterpret_cast<const bf16x8*>(Bf_ + aoff + i_ * 2048 + c_); \
        acc[i_][0] = __builtin_amdgcn_mfma_f32_32x32x16_bf16(a_, b0, acc[i_][0], 0, 0, 0); \
        acc[i_][1] = __builtin_amdgcn_mfma_f32_32x32x16_bf16(a_, b1, acc[i_][1], 0, 0, 0); \
      } \
    } \
    if (ISSUE) asm volatile("s_waitcnt vmcnt(6)" ::: "memory"); else asm volatile("s_waitcnt vmcnt(0)" ::: "memory"); \
    asm volatile("s_waitcnt lgkmcnt(0)" ::: "memory"); \
    __builtin_amdgcn_s_barrier(); } while (0)
  asm volatile("s_waitcnt vmcnt(0)" ::: "memory");
  __syncthreads();
  GLDS_STAGE(0, 0);
  GLDS_STAGE(1, 1);
  asm volatile("s_waitcnt vmcnt(6)" ::: "memory");
  asm volatile("s_waitcnt lgkmcnt(0)" ::: "memory");
  __builtin_amdgcn_s_barrier();
  int cur = 0, nx2 = 2;
#pragma unroll 1
  for (int kt = 0; kt < 32; ++kt) {
    KSTEP(kt, cur, nx2, (kt + 2 < 32));
    cur = (cur == 2) ? 0 : cur + 1;
    nx2 = (nx2 == 2) ? 0 : nx2 + 1;
  }
#undef KSTEP
#undef GLDS_STAGE
}

__device__ __forceinline__ int xcd_idx(int round) {
  const int b = blockIdx.x, G = gridDim.x;
  if ((G & 511) == 0) return ((round * (G >> 6) + ((b & 7) * (G >> 9)) + ((b >> 3) / 64)) * 64) + ((b >> 3) & 63);
  return round * G + b;
}
__device__ __forceinline__ bool xcd_tile(int round, int NT, int ntiles, int& mt, int& nt) {
  const int b = blockIdx.x, G = gridDim.x;
  int idx;
  if ((G & 511) == 0) { idx = ((round * (G >> 6) + ((b & 7) * (G >> 9)) + ((b >> 3) / 64)) * 64) + ((b >> 3) & 63); }
  else idx = round * G + b;
  if (idx >= ntiles) return false;
  int band = idx / (8 * NT), rem = idx % (8 * NT);
  nt = rem >> 3; mt = band * 8 + (rem & 7);
  return true;
}

__device__ __forceinline__ void cvt8(const float* __restrict__ s, u16* __restrict__ d) {
  float4 a = *reinterpret_cast<const float4*>(s), b = *reinterpret_cast<const float4*>(s + 4);
  uint4 o; o.x = pack2(a.x, a.y); o.y = pack2(a.z, a.w); o.z = pack2(b.x, b.y); o.w = pack2(b.z, b.w);
  *reinterpret_cast<uint4*>(d) = o;
}
__device__ __forceinline__ void transpose_w(const float* __restrict__ W, int N, int Npad, u16* __restrict__ Wt, int srcmap, size_t gtid, size_t gsz) {
  const size_t total = (size_t)Npad * 128;
  for (size_t id = gtid; id < total; id += gsz) {
    int n = (int)(id % Npad), kc = (int)(id / Npad);
    int src = n;
    if (srcmap == 1) { src = (n < 3072) ? n : (n < 3328 ? n + 8 : (n < 3336 ? n - 256 : -1)); }
    else if (n >= N) src = -1;
    float v[8];
#pragma unroll
    for (int j = 0; j < 8; ++j) v[j] = (src >= 0) ? W[(size_t)(kc * 8 + j) * N + src] : 0.f;
    uint4 o; o.x = pack2(v[0], v[1]); o.y = pack2(v[2], v[3]); o.z = pack2(v[4], v[5]); o.w = pack2(v[6], v[7]);
    *reinterpret_cast<uint4*>(Wt + (size_t)n * 1024 + kc * 8) = o;
  }
}
__device__ __forceinline__ void table_piece(const Params& p, int layer, int piece) {
  unsigned char* ws = p.ws;
  unsigned char* tab = ws + OFF_TAB;
  float* tsc = (float*)(ws + M_TSC);
  const int lane = tidx_() & 63, w = tidx_() >> 6;
  f32x4v tv[4][4];
#pragma unroll
  for (int i = 0; i < 4; ++i) {
    const int rr = piece * 16 + w * 4 + i; const int uv = rr >> 14;
    const float* src = (uv ? p.in[20] : p.in[19]) + (size_t)layer * 16384 * 1024 + (size_t)(rr & 16383) * 1024 + lane * 16;
#pragma unroll
    for (int q = 0; q < 4; ++q) tv[i][q] = *reinterpret_cast<const f32x4v*>(src + q * 4);
  }
  __builtin_amdgcn_sched_barrier(0);
#pragma unroll
  for (int i = 0; i < 4; ++i) {
    const int rr = piece * 16 + w * 4 + i;
    const size_t row = (size_t)layer * 32768 + rr;
    const f32x4v a = tv[i][0], b = tv[i][1], c = tv[i][2], d = tv[i][3];
    float m = fmaxf(fmaxf(fmaxf(fabsf(a.x), fabsf(a.y)), fmaxf(fabsf(a.z), fabsf(a.w))), fmaxf(fmaxf(fabsf(b.x), fabsf(b.y)), fmaxf(fabsf(b.z), fabsf(b.w))));
    m = fmaxf(m, fmaxf(fmaxf(fmaxf(fabsf(c.x), fabsf(c.y)), fmaxf(fabsf(c.z), fabsf(c.w))), fmaxf(fmaxf(fabsf(d.x), fabsf(d.y)), fmaxf(fabsf(d.z), fabsf(d.w)))));
    m = wmax(m);
    float sc = (m > 0.f) ? 416.f / m : 1.f;
    u32x4 o;
    int w0 = __builtin_amdgcn_cvt_pk_fp8_f32(a.x * sc, a.y * sc, 0, false); w0 = __builtin_amdgcn_cvt_pk_fp8_f32(a.z * sc, a.w * sc, w0, true);
    int w1 = __builtin_amdgcn_cvt_pk_fp8_f32(b.x * sc, b.y * sc, 0, false); w1 = __builtin_amdgcn_cvt_pk_fp8_f32(b.z * sc, b.w * sc, w1, true);
    int w2 = __builtin_amdgcn_cvt_pk_fp8_f32(c.x * sc, c.y * sc, 0, false); w2 = __builtin_amdgcn_cvt_pk_fp8_f32(c.z * sc, c.w * sc, w2, true);
    int w3 = __builtin_amdgcn_cvt_pk_fp8_f32(d.x * sc, d.y * sc, 0, false); w3 = __builtin_amdgcn_cvt_pk_fp8_f32(d.z * sc, d.w * sc, w3, true);
    o.x = (unsigned)w0; o.y = (unsigned)w1; o.z = (unsigned)w2; o.w = (unsigned)w3;
    *reinterpret_cast<u32x4*>(tab + row * 1024 + lane * 16) = o;
    if (lane == 0) tsc[row] = (m > 0.f) ? m / 416.f : 1.f;
  }
}
__device__ __forceinline__ void phase_prep(const Params& p) {
  const size_t gtid = (size_t)blockIdx.x * 256 + tidx_(), gsz = (size_t)gridDim.x * 256;
  unsigned char* ws = p.ws;
  {
    u16* xb = (u16*)(ws + OFF_XB);
    for (size_t g = gtid; g < (size_t)T_TOK * DM / 8; g += gsz) cvt8(p.in[0] + g * 8, xb + g * 8);
  }
  {
    u16* mb = (u16*)(ws + W_MEM);
    for (size_t g = gtid; g < (size_t)1024 * 1024 / 8; g += gsz) cvt8(p.in[1] + g * 8, mb + g * 8);
  }
  {
    u16* sk = (u16*)(ws + W_SK);
    for (size_t id = gtid; id < (size_t)2 * 2 * 4 * 8 * 64; id += gsz) {
      int lane = (int)(id & 63); int q = (int)(id >> 6);
      int ks = q & 7; q >>= 3; int kt = q & 3; q >>= 2;
      cvt8(p.in[18] + ((size_t)q * 128 + kt * 32 + (lane & 31)) * 128 + ks * 16 + 8 * (lane >> 5), sk + id * 8);
    }
  }
  transpose_w(p.in[2], 3336, 3456, (u16*)(ws + W_IN0), 1, gtid, gsz);
  transpose_w(p.in[5], 1792, 1792, (u16*)(ws + W_IN1), 0, gtid, gsz);
  for (int l = 0; l < 2; ++l) {
    transpose_w(p.in[14] + (size_t)l * 1024 * 1024, 1024, 1024, (u16*)(ws + W_OUT) + (size_t)l * 1024 * 1024, 0, gtid, gsz);
    transpose_w(p.in[17] + (size_t)l * 1024 * 2048, 2048, 2048, (u16*)(ws + W_Q) + (size_t)l * 2048 * 1024, 0, gtid, gsz);
    transpose_w(p.in[13] + (size_t)l * 1024 * 512, 512, 512, (u16*)(ws + W_KV) + (size_t)l * 512 * 1024, 0, gtid, gsz);
  }
  {
    u16* wf = (u16*)(ws + W_AF);
    for (size_t id = gtid; id < (size_t)2 * 8 * 3 * 6 * 64; id += gsz) {
      int lane = (int)(id & 63); int q = (int)(id >> 6);
      int ks = q % 6; q /= 6; int jt = q % 3; q /= 3; int g = q % 8; int mat = q / 8;
      const float* W = mat ? p.in[10] : p.in[8];
      u16 o[8];
#pragma unroll
      for (int j = 0; j < 8; ++j) o[j] = f2bf(W[((size_t)g * 96 + ks * 16 + 8 * (lane >> 5) + j) * 96 + jt * 32 + (lane & 31)]);
      uint4 ov; ov.x = o[0] | (o[1] << 16); ov.y = o[2] | (o[3] << 16); ov.z = o[4] | (o[5] << 16); ov.w = o[6] | (o[7] << 16);
      *reinterpret_cast<uint4*>(wf + id * 8) = ov;
    }
  }
}

__device__ __forceinline__ void epi_store_bf16(const f32x16 (&acc)[4][2], u16* __restrict__ Z, int ld, int m0, int n0, u16* Cs) {
  const int tid = tidx_(), lane = tid & 63, w = tid >> 6, wm = w >> 1, wn = w & 1, r = lane & 31, h = lane >> 5;
#pragma unroll
  for (int i = 0; i < 4; ++i)
#pragma unroll
    for (int j = 0; j < 2; ++j)
#pragma unroll
      for (int reg = 0; reg < 16; ++reg)
        Cs[(wm * 128 + i * 32 + crow(reg, h)) * 136 + wn * 64 + j * 32 + r] = f2bf(acc[i][j][reg]);
  __syncthreads();
#pragma unroll 4
  for (int q = tid; q < 256 * 16; q += 256) {
    int row = q >> 4, cc = q & 15;
    *reinterpret_cast<uint4*>(Z + (size_t)(m0 + row) * ld + n0 + cc * 8) = *reinterpret_cast<const uint4*>(Cs + row * 136 + cc * 8);
  }
}
__device__ __forceinline__ void phase_inproj(const Params& p, int layer, unsigned char* smem) {
  unsigned char* ws = p.ws;
  const u16* xb = (const u16*)(ws + OFF_XB);
  u16* Z = (u16*)(ws + OFF_Z);
  const int NT = layer == 0 ? 27 : 14;
  const int nmain = 64 * NT;
  const int nitems = nmain + (layer == 0 ? 32 : 0);
  const int tid = tidx_(), lane = tid & 63, w = tid >> 6, wm = w >> 1, wn = w & 1, r = lane & 31, h = lane >> 5;
  const int rounds_main = (nmain + gridDim.x - 1) / gridDim.x;
  const int nidle = rounds_main * (int)gridDim.x - nmain;
  const int nkv = nitems - nmain;
  const bool kv_in_idle = nidle >= nkv + 64;
  for (int rd = 0; rd < rounds_main + 1; ++rd) {
    f32x16 acc[4][2];
    int nt = 0, mt = 0, it = 0;
    bool main_tile = false;
    if (rd < rounds_main) {
      main_tile = xcd_tile(rd, NT, nmain, mt, nt);
      if (!main_tile) {
        const int j = xcd_idx(rd) - nmain;
        if (kv_in_idle && j < nkv) it = nmain + j;
        else {
          const int j2 = kv_in_idle ? j - nkv : j, n2 = kv_in_idle ? nidle - nkv : nidle;
          const int pc_lo = layer == 0 ? 0 : 3072, pc_hi = layer == 0 ? 3072 : 4096;
          for (int pc = pc_lo + j2; pc < pc_hi; pc += n2) table_piece(p, pc >> 11, pc & 2047);
          continue;
        }
      }
    }
    else { if (kv_in_idle) continue; it = nmain + blockIdx.x; if (it >= nitems) continue; }
    if (main_tile) {
      const u16* Wt = (const u16*)(ws + (layer == 0 ? W_IN0 : W_IN1));
      gemm_mainloop(xb, Wt, mt * 256, nt * 128, (u16*)smem, acc);
      if (layer == 0 && nt == 26) {
        float* gates = (float*)(ws + M_GATES);
        if (wn == 0 && r < 8) {
#pragma unroll
          for (int i = 0; i < 4; ++i)
#pragma unroll
            for (int reg = 0; reg < 16; ++reg) {
              int row = mt * 256 + wm * 128 + i * 32 + crow(reg, h);
              gates[(size_t)row * 8 + r] = acc[i][0][reg];
            }
        }
      } else {
        epi_store_bf16(acc, Z, layer == 0 ? ZLD0 : ZLD1, mt * 256, nt * 128, (u16*)smem);
      }
    } else {
      int q = it - nmain; int lay = q >> 4; mt = (q >> 2) & 3; nt = q & 3;
      const u16* memb = (const u16*)(ws + W_MEM);
      const u16* Wt = (const u16*)(ws + W_KV) + (size_t)lay * 512 * 1024;
      gemm_mainloop(memb, Wt, mt * 256, nt * 128, (u16*)smem, acc);
      u16* Kf = (u16*)(ws + M_KF) + (size_t)lay * 262144;
      u16* Vf = (u16*)(ws + M_VF) + (size_t)lay * 262144;
#pragma unroll
      for (int i = 0; i < 4; ++i)
#pragma unroll
        for (int j = 0; j < 2; ++j)
#pragma unroll
          for (int reg = 0; reg < 16; ++reg) {
            int row = mt * 256 + wm * 128 + i * 32 + crow(reg, h), col = nt * 128 + wn * 64 + j * 32 + r;
            int b = row >> 8, m = row & 255;
            u16 v = f2bf(acc[i][j][reg]);
            if (col < 256) {
              int head = col >> 6, d = col & 63;
              size_t idx = ((((size_t)(b * 4 + head) * 8 + (m >> 5)) * 4 + (d >> 4)) * 512) + ((((d >> 3) & 1) * 32 + (m & 31)) * 8) + (d & 7);
              Kf[idx] = v;
            } else {
              int c2 = col - 256; int head = c2 >> 6, d = c2 & 63;
              size_t idx = ((((size_t)(b * 4 + head) * 2 + (d >> 5)) * 16 + (m >> 4)) * 512) + ((((m >> 3) & 1) * 32 + (d & 31)) * 8) + (m & 7);
              Vf[idx] = v;
            }
          }
    }
  }
  if (rounds_main * (int)gridDim.x == nmain) {
    const int pc_lo = layer == 0 ? 0 : 3072, pc_hi = layer == 0 ? 3072 : 4096;
    for (int pc2 = pc_lo + (int)blockIdx.x; pc2 < pc_hi; pc2 += (int)gridDim.x) table_piece(p, pc2 >> 11, pc2 & 2047);
  }
}
__device__ __forceinline__ void phase_outproj(const Params& p, int layer, unsigned char* smem) {
  unsigned char* ws = p.ws;
  const u16* cat = (const u16*)(ws + OFF_CAT);
  const u16* Wt = (const u16*)(ws + W_OUT) + (size_t)layer * 1024 * 1024;
  const float* res = layer == 0 ? p.in[0] : p.out;
  float* pre = (float*)(ws + OFF_Z);
  const int tid = tidx_(), lane = tid & 63, w = tid >> 6, wm = w >> 1, wn = w & 1, r = lane & 31, h = lane >> 5;
  for (int rd = 0; rd < (512 + (int)gridDim.x - 1) / (int)gridDim.x; ++rd) {
    int nt, mt;
    if (!xcd_tile(rd, 8, 512, mt, nt)) continue;
    f32x16 acc[4][2];
    gemm_mainloop(cat, Wt, mt * 256, nt * 128, (u16*)smem, acc);
    float* Cs = (float*)smem;
#pragma unroll 1
    for (int hf = 0; hf < 2; ++hf) {
      if (wm == hf) {
#pragma unroll
        for (int i = 0; i < 4; ++i)
#pragma unroll
          for (int j = 0; j < 2; ++j)
#pragma unroll
            for (int reg = 0; reg < 16; ++reg) Cs[(i * 32 + crow(reg, h)) * 132 + wn * 64 + j * 32 + r] = acc[i][j][reg];
      }
      __syncthreads();
#pragma unroll 1
      for (int q0 = tid; q0 < 128 * 32; q0 += 256 * 8) {
        f32x4v rv[8];
#pragma unroll
        for (int u = 0; u < 8; ++u) {
          int q = q0 + u * 256; int row = q >> 5, c4 = q & 31;
          rv[u] = *reinterpret_cast<const f32x4v*>(res + (size_t)(mt * 256 + hf * 128 + row) * 1024 + nt * 128 + c4 * 4);
        }
        __builtin_amdgcn_sched_barrier(0);
#pragma unroll
        for (int u = 0; u < 8; ++u) {
          int q = q0 + u * 256; int row = q >> 5, c4 = q & 31;
          f32x4v cv = *reinterpret_cast<const f32x4v*>(Cs + row * 132 + c4 * 4);
          f32x4v ov; ov.x = DN_ALPHA * rv[u].x + cv.x; ov.y = DN_ALPHA * rv[u].y + cv.y; ov.z = DN_ALPHA * rv[u].z + cv.z; ov.w = DN_ALPHA * rv[u].w + cv.w;
          *reinterpret_cast<f32x4v*>(pre + (size_t)(mt * 256 + hf * 128 + row) * 1024 + nt * 128 + c4 * 4) = ov;
        }
      }
      __syncthreads();
    }
  }
}

__device__ __forceinline__ void phase_ln1(const Params& p, int layer) {
  unsigned char* ws = p.ws;
  const float* pre = (const float*)(ws + OFF_Z);
  u16* xb = (u16*)(ws + OFF_XB);
  const float* g = p.in[15] + layer * 1024; const float* bb = p.in[16] + layer * 1024;
  const int lane = tidx_() & 63, w = tidx_() >> 6;
  f32x4v gg[4], b4[4];
#pragma unroll
  for (int i = 0; i < 4; ++i) { gg[i] = *reinterpret_cast<const f32x4v*>(g + i * 256 + lane * 4); b4[i] = *reinterpret_cast<const f32x4v*>(bb + i * 256 + lane * 4); }
  const int rstride = gridDim.x * 4;
  for (int row0 = blockIdx.x * 4 + w; row0 < T_TOK; row0 += 2 * rstride) {
    const int row1 = row0 + rstride;
    const bool has1 = row1 < T_TOK;
    f32x4v v[2][4];
#pragma unroll
    for (int i = 0; i < 4; ++i) {
      v[0][i] = *reinterpret_cast<const f32x4v*>(pre + (size_t)row0 * 1024 + i * 256 + lane * 4);
      v[1][i] = *reinterpret_cast<const f32x4v*>(pre + (size_t)(has1 ? row1 : row0) * 1024 + i * 256 + lane * 4);
    }
    __builtin_amdgcn_sched_barrier(0);
#pragma unroll
    for (int rr = 0; rr < 2; ++rr) {
      if (rr == 1 && !has1) break;
      const int row = rr ? row1 : row0;
      float s = 0.f;
#pragma unroll
      for (int i = 0; i < 4; ++i) s += v[rr][i].x + v[rr][i].y + v[rr][i].z + v[rr][i].w;
      float mu = wsum(s) * (1.f / 1024.f);
      float q = 0.f;
#pragma unroll
      for (int i = 0; i < 4; ++i) { float a = v[rr][i].x - mu, b = v[rr][i].y - mu, c = v[rr][i].z - mu, d = v[rr][i].w - mu; q += a * a + b * b + c * c + d * d; }
      float rstd = rsqrtf(wsum(q) * (1.f / 1024.f) + LN_EPS);
#pragma unroll
      for (int i = 0; i < 4; ++i) {
        int c0 = i * 256 + lane * 4;
        uint2 o; o.x = pack2((v[rr][i].x - mu) * rstd * gg[i].x + b4[i].x, (v[rr][i].y - mu) * rstd * gg[i].y + b4[i].y);
        o.y = pack2((v[rr][i].z - mu) * rstd * gg[i].z + b4[i].z, (v[rr][i].w - mu) * rstd * gg[i].w + b4[i].w);
        *reinterpret_cast<uint2*>(xb + (size_t)row * 1024 + c0) = o;
      }
    }
  }
}

__device__ __forceinline__ void mlstm_A(const Params& p, int item, unsigned char* smem) {
  unsigned char* ws = p.ws;
  const int tid = tidx_(), lane = tid & 63, w = tid >> 6, r = lane & 31, h2 = lane >> 5;
  const int bh = item >> 6, c = item & 63, b = bh >> 2, hd = bh & 3;
  const int t0 = b * SEQ + c * 64;
  const u16* Z = (const u16*)(ws + OFF_Z);
  const float* gates = (const float*)(ws + M_GATES);
  const float* bg = p.in[3];
  u16* Ks = (u16*)smem; u16* Vs = Ks + 64 * 200; float* wgt = (float*)(Vs + 64 * 200);
  __syncthreads();
  if (tid < 64) {
    float ii = gates[(size_t)(t0 + tid) * 8 + hd] + bg[hd];
    float ff = logsigmoidf_(gates[(size_t)(t0 + tid) * 8 + 4 + hd] + bg[4 + hd]);
    float bc = ff;
#pragma unroll
    for (int o = 1; o < 64; o <<= 1) { float t = __shfl_up(bc, o); if (tid >= o) bc += t; }
    float a = ii - bc;
    float M = wmax(a);
    float bl = __shfl(bc, 63);
    wgt[tid] = expf(a - M);
    if (tid == 0) { ((float*)(ws + M_STBL))[bh * 64 + c] = bl; ((float*)(ws + M_STML))[bh * 64 + c] = bl + M; }
  }
  __syncthreads();
  {
    u32x4 kvr[6], vvr[6];
#pragma unroll
    for (int it = 0; it < 6; ++it) {
      int q = tid + it * 256; int l = q / 24, dc = q % 24;
      const u16* zr = Z + (size_t)(t0 + l) * ZLD0 + hd * 192 + dc * 8;
      kvr[it] = *reinterpret_cast<const u32x4*>(zr + 768);
      vvr[it] = *reinterpret_cast<const u32x4*>(zr + 1536);
    }
    __builtin_amdgcn_sched_barrier(0);
#pragma unroll
    for (int it = 0; it < 6; ++it) {
      int q = tid + it * 256; int l = q / 24, dc = q % 24;
      float sc = wgt[l] * 0.07216878364870322f;
      u32x4 kv = kvr[it], ko;
      ko.x = pack2(bflo(kv.x) * sc, bfhi(kv.x) * sc); ko.y = pack2(bflo(kv.y) * sc, bfhi(kv.y) * sc);
      ko.z = pack2(bflo(kv.z) * sc, bfhi(kv.z) * sc); ko.w = pack2(bflo(kv.w) * sc, bfhi(kv.w) * sc);
      *reinterpret_cast<u32x4*>(Ks + l * 200 + dc * 8) = ko;
      *reinterpret_cast<u32x4*>(Vs + l * 200 + dc * 8) = vvr[it];
    }
  }
  __syncthreads();
  u16* KV = (u16*)(ws + OFF_SCR) + (size_t)(bh * 64 + c) * 36864;
  for (int tt = w; tt < 36; tt += 4) {
    int dt = tt / 6, et = tt % 6;
    f32x16 acc = zero16();
#pragma unroll
    for (int ks = 0; ks < 4; ++ks) {
      bf16x8 a = ldsfrag_strided(Ks + (ks * 16 + 8 * h2) * 200 + dt * 32 + r, 200);
      bf16x8 bb = ldsfrag_strided(Vs + (ks * 16 + 8 * h2) * 200 + et * 32 + r, 200);
      acc = __builtin_amdgcn_mfma_f32_32x32x16_bf16(a, bb, acc, 0, 0, 0);
    }
#pragma unroll
    for (int g = 0; g < 4; ++g) {
      size_t idx = ((size_t)(et * 12 + dt * 2 + (g >> 1)) * 64 + (g & 1) * 32 + r) * 8 + 4 * h2;
      uint2 o; o.x = pack2(acc[g * 4 + 0], acc[g * 4 + 1]); o.y = pack2(acc[g * 4 + 2], acc[g * 4 + 3]);
      *reinterpret_cast<uint2*>(KV + idx) = o;
    }
  }
  if (tid < 192) {
    float s = 0.f;
    for (int l = 0; l < 64; ++l) s += bf2f(Ks[l * 200 + tid]);
    ((float*)(ws + M_NLOC))[(size_t)(bh * 64 + c) * 192 + tid] = s;
  }
}

__device__ __forceinline__ void phase_mlstm_scan(const Params& p) {
  unsigned char* ws = p.ws;
  const size_t gtid = (size_t)blockIdx.x * 256 + tidx_(), gsz = (size_t)gridDim.x * 256;
  const float* stbl = (const float*)(ws + M_STBL); const float* stml = (const float*)(ws + M_STML);
  const u16* KV = (const u16*)(ws + OFF_SCR);
  u16* Cin = (u16*)(ws + OFF_SCR + 72 * MiB);
  for (size_t qid = gtid; qid < (size_t)16 * 4608; qid += gsz) {
    int bh = (int)(qid / 4608), qi = (int)(qid % 4608);
    float C[8], m = 0.f;
#pragma unroll
    for (int i = 0; i < 8; ++i) C[i] = 0.f;
    const size_t ob = (size_t)(bh * 64) * 36864 + (size_t)qi * 8;
    u32x4 nx[8];
#pragma unroll
    for (int j = 0; j < 8; ++j) nx[j] = *reinterpret_cast<const u32x4*>(KV + ob + (size_t)j * 36864);
#pragma unroll 1
    for (int c0 = 0; c0 < 64; c0 += 8) {
      u32x4 cur[8];
#pragma unroll
      for (int j = 0; j < 8; ++j) cur[j] = nx[j];
      if (c0 + 8 < 64) {
#pragma unroll
        for (int j = 0; j < 8; ++j) nx[j] = *reinterpret_cast<const u32x4*>(KV + ob + (size_t)(c0 + 8 + j) * 36864);
      }
      __builtin_amdgcn_sched_barrier(0);
#pragma unroll
      for (int j = 0; j < 8; ++j) {
        const int c = c0 + j;
        float bl = stbl[bh * 64 + c], ml = stml[bh * 64 + c];
        float mn = fmaxf(bl + m, ml);
        float dec = expf(bl + m - mn), wl = expf(ml - mn);
        u32x4 kv = cur[j], co;
        co.x = pack2(C[0], C[1]); co.y = pack2(C[2], C[3]); co.z = pack2(C[4], C[5]); co.w = pack2(C[6], C[7]);
        *reinterpret_cast<u32x4*>(Cin + ob + (size_t)c * 36864) = co;
        C[0] = dec * C[0] + wl * bflo(kv.x); C[1] = dec * C[1] + wl * bfhi(kv.x);
        C[2] = dec * C[2] + wl * bflo(kv.y); C[3] = dec * C[3] + wl * bfhi(kv.y);
        C[4] = dec * C[4] + wl * bflo(kv.z); C[5] = dec * C[5] + wl * bfhi(kv.z);
        C[6] = dec * C[6] + wl * bflo(kv.w); C[7] = dec * C[7] + wl * bfhi(kv.w);
        m = mn;
      }
    }
  }
  const float* nloc = (const float*)(ws + M_NLOC); float* nin = (float*)(ws + M_NIN); float* minp = (float*)(ws + M_MIN);
  const size_t rtid = (size_t)(gridDim.x - 1 - blockIdx.x) * 256 + tidx_();
  for (size_t id = rtid; id < (size_t)16 * 192; id += gsz) {
    int bh = (int)(id / 192), d = (int)(id % 192);
    float n = 0.f, m = 0.f;
#pragma unroll 1
    for (int c0 = 0; c0 < 64; c0 += 16) {
      float nl[16];
#pragma unroll
      for (int j = 0; j < 16; ++j) nl[j] = nloc[(size_t)(bh * 64 + c0 + j) * 192 + d];
      __builtin_amdgcn_sched_barrier(0);
#pragma unroll
      for (int j = 0; j < 16; ++j) {
        const int c = c0 + j;
        float bl = stbl[bh * 64 + c], ml = stml[bh * 64 + c];
        float mn = fmaxf(bl + m, ml);
        float dec = expf(bl + m - mn), wl = expf(ml - mn);
        size_t o = (size_t)(bh * 64 + c) * 192 + d;
        nin[o] = n;
        if (d == 0) minp[bh * 64 + c] = m;
        n = dec * n + wl * nl[j];
        m = mn;
      }
    }
  }
}

__device__ __forceinline__ void mlstm_C(const Params& p, int item, unsigned char* smem) {
  unsigned char* ws = p.ws;
  const int tid = tidx_(), lane = tid & 63, w = tid >> 6, r = lane & 31, h2 = lane >> 5;
  const int bh = item >> 7, c = (item >> 1) & 63, half = item & 1, b = bh >> 2, hd = bh & 3;
  const int t0 = b * SEQ + c * 64, l0 = half * 32;
  const u16* Z = (const u16*)(ws + OFF_Z);
  const float* gates = (const float*)(ws + M_GATES);
  const float* bg = p.in[3];
  u16* Qs = (u16*)smem;
  u16* Ks = Qs + 32 * 200;
  u16* Vs = Ks + 64 * 200;
  float* Ss = (float*)(Vs + 64 * 200);
  u16* Ps = (u16*)(Ss + 32 * 72);
  float* sA = (float*)(Ps + 32 * 72);
  float* sG = sA + 64;
  float* sSc = sG + 64;
  float* sEm = sSc + 64;
  float* sQn = sEm + 64;
  float* sInv = sQn + 32;
  float* sN = sInv + 32;
  float* Hs = (float*)Ks;
  __syncthreads();
  if (tid < 64) {
    float ii = gates[(size_t)(t0 + tid) * 8 + hd] + bg[hd];
    float ff = logsigmoidf_(gates[(size_t)(t0 + tid) * 8 + 4 + hd] + bg[4 + hd]);
    float bc = ff;
#pragma unroll
    for (int o = 1; o < 64; o <<= 1) { float t = __shfl_up(bc, o); if (tid >= o) bc += t; }
    float a = ii - bc;
    float M = a;
#pragma unroll
    for (int o = 1; o < 64; o <<= 1) { float t = __shfl_up(M, o); if (tid >= o) M = fmaxf(M, t); }
    float m_in = ((const float*)(ws + M_MIN))[bh * 64 + c];
    float g = fmaxf(M, m_in);
    sA[tid] = a; sG[tid] = g; sSc[tid] = expf(m_in - g); sEm[tid] = expf(-(bc + g));
  }
  {
    u32x4 kvr[6], vvr[6], qvr[3];
#pragma unroll
    for (int it = 0; it < 6; ++it) {
      int q = tid + it * 256; int l = q / 24, dc = q % 24;
      const u16* zr = Z + (size_t)(t0 + l) * ZLD0 + hd * 192 + dc * 8;
      kvr[it] = *reinterpret_cast<const u32x4*>(zr + 768);
      vvr[it] = *reinterpret_cast<const u32x4*>(zr + 1536);
      if (it < 3) qvr[it] = *reinterpret_cast<const u32x4*>(Z + (size_t)(t0 + l0 + l) * ZLD0 + hd * 192 + dc * 8);
    }
    if (tid < 192) sN[tid] = ((const float*)(ws + M_NIN))[(size_t)(bh * 64 + c) * 192 + tid];
    __builtin_amdgcn_sched_barrier(0);
#pragma unroll
    for (int it = 0; it < 6; ++it) {
      int q = tid + it * 256; int l = q / 24, dc = q % 24;
      const float sc = 0.07216878364870322f;
      u32x4 kv = kvr[it], ko;
      ko.x = pack2(bflo(kv.x) * sc, bfhi(kv.x) * sc); ko.y = pack2(bflo(kv.y) * sc, bfhi(kv.y) * sc);
      ko.z = pack2(bflo(kv.z) * sc, bfhi(kv.z) * sc); ko.w = pack2(bflo(kv.w) * sc, bfhi(kv.w) * sc);
      *reinterpret_cast<u32x4*>(Ks + l * 200 + dc * 8) = ko;
      *reinterpret_cast<u32x4*>(Vs + l * 200 + dc * 8) = vvr[it];
      if (it < 3) *reinterpret_cast<u32x4*>(Qs + l * 200 + dc * 8) = qvr[it];
    }
  }
  __syncthreads();
  if (w < 2) {
    f32x16 acc = zero16();
#pragma unroll
    for (int ks = 0; ks < 12; ++ks) {
      bf16x8 a = ldsfrag(Qs + r * 200 + ks * 16 + h2 * 8);
      bf16x8 bb = ldsfrag(Ks + (w * 32 + r) * 200 + ks * 16 + h2 * 8);
      acc = __builtin_amdgcn_mfma_f32_32x32x16_bf16(a, bb, acc, 0, 0, 0);
    }
#pragma unroll
    for (int reg = 0; reg < 16; ++reg) Ss[crow(reg, h2) * 72 + w * 32 + r] = acc[reg];
  } else {
    int t2 = tid - 128; int l = t2 >> 2, part = t2 & 3;
    float s = 0.f;
    for (int d = part * 48; d < part * 48 + 48; ++d) s += bf2f(Qs[l * 200 + d]) * sN[d];
    s += __shfl_xor(s, 1); s += __shfl_xor(s, 2);
    if (part == 0) sQn[l] = s;
  }
  __syncthreads();
  {
    int l = tid >> 3, sub = tid & 7; int L = l0 + l;
    float gL = sG[L]; float rs = 0.f;
#pragma unroll
    for (int i = 0; i < 8; ++i) {
      int s = sub + 8 * i;
      float pv = 0.f;
      if (s <= L) pv = Ss[l * 72 + s] * expf(sA[s] - gL);
      rs += pv;
      Ps[l * 72 + s] = f2bf(pv);
    }
    rs += __shfl_xor(rs, 1); rs += __shfl_xor(rs, 2); rs += __shfl_xor(rs, 4);
    if (sub == 0) {
      float den = sSc[L] * sQn[l] + rs;
      sInv[l] = 1.f / fmaxf(fabsf(den), sEm[L]);
    }
  }
  __syncthreads();
  const u16* Cin = (const u16*)(ws + OFF_SCR + 72 * MiB) + (size_t)(bh * 64 + c) * 36864;
  for (int et = w; et < 6; et += 4) {
    f32x16 acc = zero16();
    const u16* cf = Cin + (size_t)(et * 12) * 512 + lane * 8;
    bf16x8 cfr[12];
#pragma unroll
    for (int ks = 0; ks < 12; ++ks) cfr[ks] = gfrag(cf + ks * 512);
    __builtin_amdgcn_sched_barrier(0);
#pragma unroll
    for (int ks = 0; ks < 12; ++ks) {
      bf16x8 a = ldsfrag(Qs + r * 200 + ks * 16 + h2 * 8);
      acc = __builtin_amdgcn_mfma_f32_32x32x16_bf16(a, cfr[ks], acc, 0, 0, 0);
    }
#pragma unroll
    for (int reg = 0; reg < 16; ++reg) acc[reg] *= sSc[l0 + crow(reg, h2)];
#pragma unroll
    for (int ks = 0; ks < 4; ++ks) {
      bf16x8 a = ldsfrag(Ps + r * 72 + ks * 16 + h2 * 8);
      bf16x8 bb = ldsfrag_strided(Vs + (ks * 16 + 8 * h2) * 200 + et * 32 + r, 200);
      acc = __builtin_amdgcn_mfma_f32_32x32x16_bf16(a, bb, acc, 0, 0, 0);
    }
#pragma unroll
    for (int reg = 0; reg < 16; ++reg) { int row = crow(reg, h2); Hs[row * 196 + et * 32 + r] = acc[reg] * sInv[row]; }
  }
  __syncthreads();
  {
    int l = tid >> 3, sub = tid & 7;
    float s = 0.f;
    for (int i = 0; i < 24; ++i) s += Hs[l * 196 + sub + 8 * i];
    s += __shfl_xor(s, 1); s += __shfl_xor(s, 2); s += __shfl_xor(s, 4);
    float mu = s * (1.f / 192.f);
    float q = 0.f;
    for (int i = 0; i < 24; ++i) { float d = Hs[l * 196 + sub + 8 * i] - mu; q += d * d; }
    q += __shfl_xor(q, 1); q += __shfl_xor(q, 2); q += __shfl_xor(q, 4);
    float rstd = rsqrtf(q * (1.f / 192.f) + LN_EPS);
    const float* ng = p.in[4] + hd * 192;
    size_t tok = (size_t)(t0 + l0 + l);
    const u16* orow = Z + tok * ZLD0 + 2304 + hd * 192;
    u16* cat = (u16*)(ws + OFF_CAT) + tok * 1024 + hd * 192;
    float ngv[24], ov[24];
#pragma unroll
    for (int i = 0; i < 24; ++i) { ngv[i] = ng[sub + 8 * i]; ov[i] = bf2f(orow[sub + 8 * i]); }
    __builtin_amdgcn_sched_barrier(0);
#pragma unroll
    for (int i = 0; i < 24; ++i) {
      int e = sub + 8 * i;
      float hn = (Hs[l * 196 + e] - mu) * rstd * ngv[i];
      cat[e] = f2bf(hn * sigmoidf_(ov[i]));
    }
  }
}

__device__ __forceinline__ void xattn_item(const Params& p, int layer, int item, unsigned char* smem) {
  unsigned char* ws = p.ws;
  const int tid = tidx_(), lane = tid & 63, w = tid >> 6, r = lane & 31, h2 = lane >> 5;
  const int head = item & 3, tt = item >> 2;
  const int tok0 = tt * 32, b = tok0 / SEQ;
  const u16* Z = (const u16*)(ws + OFF_Z);
  const int zld = layer == 0 ? ZLD0 : ZLD1, xq = layer == 0 ? 3072 : 1536;
  const u16* Kf = (const u16*)(ws + M_KF) + (size_t)layer * 262144 + (size_t)(b * 4 + head) * 8 * 4 * 512;
  const u16* Vf = (const u16*)(ws + M_VF) + (size_t)layer * 262144 + (size_t)(b * 4 + head) * 2 * 16 * 512;
  u16* Qs = (u16*)smem;
  float* Ss = (float*)(Qs + 32 * 72);
  u16* Ps = (u16*)(Ss + 32 * 264);
  float* rinv = (float*)(Ps + 32 * 264);
  __syncthreads();
  bf16x8 kf[8];
#pragma unroll
  for (int i = 0; i < 8; ++i) kf[i] = gfrag(Kf + (size_t)(w * 8 + i) * 512 + lane * 8);
  {
    int l = tid >> 3, cc = tid & 7;
    u32x4 qv = *reinterpret_cast<const u32x4*>(Z + (size_t)(tok0 + l) * zld + xq + head * 64 + cc * 8);
    __builtin_amdgcn_sched_barrier(0);
    *reinterpret_cast<u32x4*>(Qs + l * 72 + cc * 8) = qv;
  }
  __syncthreads();
#pragma unroll
  for (int mm = 0; mm < 2; ++mm) {
    int mt = w * 2 + mm;
    f32x16 acc = zero16();
#pragma unroll
    for (int ks = 0; ks < 4; ++ks) {
      bf16x8 a = ldsfrag(Qs + r * 72 + ks * 16 + h2 * 8);
      acc = __builtin_amdgcn_mfma_f32_32x32x16_bf16(a, kf[mm * 4 + ks], acc, 0, 0, 0);
    }
#pragma unroll
    for (int reg = 0; reg < 16; ++reg) Ss[crow(reg, h2) * 264 + mt * 32 + r] = acc[reg] * 0.125f;
  }
  bf16x8 vf[16];
  if (w < 2) {
#pragma unroll
    for (int ks = 0; ks < 16; ++ks) vf[ks] = gfrag(Vf + (size_t)(w * 16 + ks) * 512 + lane * 8);
  }
  __builtin_amdgcn_sched_barrier(0);
  __syncthreads();
  {
    int l = tid >> 3, sub = tid & 7;
    float mx = -3.0e38f;
    float sv[32];
#pragma unroll
    for (int i = 0; i < 32; ++i) { sv[i] = Ss[l * 264 + sub + 8 * i]; mx = fmaxf(mx, sv[i]); }
    mx = fmaxf(mx, __shfl_xor(mx, 1)); mx = fmaxf(mx, __shfl_xor(mx, 2)); mx = fmaxf(mx, __shfl_xor(mx, 4));
    float s = 0.f;
#pragma unroll
    for (int i = 0; i < 32; ++i) { float e = __expf(sv[i] - mx); Ps[l * 264 + sub + 8 * i] = f2bf(e); s += e; }
    s += __shfl_xor(s, 1); s += __shfl_xor(s, 2); s += __shfl_xor(s, 4);
    if (sub == 0) rinv[l] = 1.f / s;
  }
  __syncthreads();
  if (w < 2) {
    f32x16 acc = zero16();
#pragma unroll
    for (int ks = 0; ks < 16; ++ks) {
      bf16x8 a = ldsfrag(Ps + r * 264 + ks * 16 + h2 * 8);
      acc = __builtin_amdgcn_mfma_f32_32x32x16_bf16(a, vf[ks], acc, 0, 0, 0);
    }
    u16* cat = (u16*)(ws + OFF_CAT);
#pragma unroll
    for (int reg = 0; reg < 16; ++reg) cat[(size_t)(tok0 + crow(reg, h2)) * 1024 + 768 + head * 64 + w * 32 + r] = f2bf(acc[reg] * rinv[crow(reg, h2)]);
  }
}

__device__ __forceinline__ void rglru_1(const Params& p, int item, unsigned char* smem) {
  unsigned char* ws = p.ws;
  const int tid = tidx_(), lane = tid & 63, w = tid >> 6, r = lane & 31, h2 = lane >> 5;
  const int b = item >> 7, c = item & 127;
  const int t0 = b * SEQ + c * 32;
  const u16* Z = (const u16*)(ws + OFF_Z);
  const float* cw = p.in[6]; const float* cb = p.in[7];
  u16* xc = (u16*)smem;
  float* PA = (float*)(ws + OFF_SCR); float* HU = (float*)(ws + OFF_SCR + 48 * MiB);
  __syncthreads();
#pragma unroll 1
  for (int q = tid; q < 32 * 96; q += 256) {
    int l = q / 96, cc = q % 96, ch0 = cc * 8;
    u32x4 xv[4]; f32x4v wlo[4], whi[4];
#pragma unroll
    for (int j = 0; j < 4; ++j) {
      int pp = c * 32 + l - 3 + j; int ppc = pp < 0 ? 0 : pp;
      xv[j] = *reinterpret_cast<const u32x4*>(Z + (size_t)(b * SEQ + ppc) * ZLD1 + 768 + ch0);
      wlo[j] = *reinterpret_cast<const f32x4v*>(cw + j * 768 + ch0); whi[j] = *reinterpret_cast<const f32x4v*>(cw + j * 768 + ch0 + 4);
    }
    float4 c0 = *reinterpret_cast<const float4*>(cb + ch0), c1 = *reinterpret_cast<const float4*>(cb + ch0 + 4);
    __builtin_amdgcn_sched_barrier(0);
    float a[8] = {c0.x, c0.y, c0.z, c0.w, c1.x, c1.y, c1.z, c1.w};
#pragma unroll
    for (int j = 0; j < 4; ++j) {
      const float vm = (c * 32 + l - 3 + j) >= 0 ? 1.f : 0.f;
      a[0] += vm * wlo[j].x * bflo(xv[j].x); a[1] += vm * wlo[j].y * bfhi(xv[j].x); a[2] += vm * wlo[j].z * bflo(xv[j].y); a[3] += vm * wlo[j].w * bfhi(xv[j].y);
      a[4] += vm * whi[j].x * bflo(xv[j].z); a[5] += vm * whi[j].y * bfhi(xv[j].z); a[6] += vm * whi[j].z * bflo(xv[j].w); a[7] += vm * whi[j].w * bfhi(xv[j].w);
    }
    uint4 o; o.x = pack2(a[0], a[1]); o.y = pack2(a[2], a[3]); o.z = pack2(a[4], a[5]); o.w = pack2(a[6], a[7]);
    *reinterpret_cast<uint4*>(xc + l * 776 + ch0) = o;
  }
  __syncthreads();
  const u16* Waf = (const u16*)(ws + W_AF); const u16* Wxf = Waf + 8 * 3 * 6 * 512;
  const float* ba = p.in[9]; const float* bx = p.in[11]; const float* lam = p.in[12];
  float* As_ = (float*)(smem + 49664);
  float* Us_ = As_ + 32 * 97;
  float* sumP = (float*)(ws + M_SUMP); float* sumH = (float*)(ws + M_SUMH);
  bf16x8 b1[6], b2[6];
  if (w < 3) {
#pragma unroll
    for (int ks = 0; ks < 6; ++ks) {
      b1[ks] = gfrag(Waf + (size_t)((0 * 3 + w) * 6 + ks) * 512 + lane * 8);
      b2[ks] = gfrag(Wxf + (size_t)((0 * 3 + w) * 6 + ks) * 512 + lane * 8);
    }
  }
#pragma unroll 1
  for (int g = 0; g < 8; ++g) {
    if (w < 3) {
      const int jt = w;
      f32x16 aa = zero16(), ax = zero16();
#pragma unroll
      for (int ks = 0; ks < 6; ++ks) {
        bf16x8 a = ldsfrag(xc + r * 776 + g * 96 + ks * 16 + h2 * 8);
        aa = __builtin_amdgcn_mfma_f32_32x32x16_bf16(a, b1[ks], aa, 0, 0, 0);
        ax = __builtin_amdgcn_mfma_f32_32x32x16_bf16(a, b2[ks], ax, 0, 0, 0);
      }
      __builtin_amdgcn_sched_barrier(0);
      if (g + 1 < 8) {
#pragma unroll
        for (int ks = 0; ks < 6; ++ks) {
          b1[ks] = gfrag(Waf + (size_t)(((g + 1) * 3 + jt) * 6 + ks) * 512 + lane * 8);
          b2[ks] = gfrag(Wxf + (size_t)(((g + 1) * 3 + jt) * 6 + ks) * 512 + lane * 8);
        }
      }
      __builtin_amdgcn_sched_barrier(0);
      const int chl = jt * 32 + r, ch = g * 96 + chl;
      const float bav = ba[ch], bxv = bx[ch], spl = softplusf_(-lam[ch]);
#pragma unroll
      for (int reg = 0; reg < 16; ++reg) {
        int l = crow(reg, h2);
        float rr = __builtin_amdgcn_rcpf(1.f + __expf(-(aa[reg] + bav))), ig = __builtin_amdgcn_rcpf(1.f + __expf(-(ax[reg] + bxv)));
        float la = -8.f * rr * spl;
        float av = __expf(la);
        float x2 = 2.f * la;
        float om_t = -x2 * (1.f + x2 * 0.5f * (1.f + x2 * (1.f / 3.f) * (1.f + x2 * 0.25f * (1.f + x2 * 0.2f))));
        float om = (x2 > -0.1f) ? om_t : (1.f - av * av);
        As_[l * 97 + chl] = av;
        Us_[l * 97 + chl] = __builtin_amdgcn_sqrtf(om) * ig * bf2f(xc[l * 776 + ch]);
      }
    }
    __syncthreads();
    if (tid < 96) {
      const int ch = g * 96 + tid;
      float P = 1.f, H = 0.f;
#pragma unroll 8
      for (int l = 0; l < 32; ++l) {
        float a = As_[l * 97 + tid], u = Us_[l * 97 + tid];
        H = a * H + u; P *= a;
        size_t o = (size_t)(t0 + l) * 768 + ch;
        PA[o] = P; HU[o] = H;
      }
      sumP[(size_t)(b * 128 + c) * 768 + ch] = P; sumH[(size_t)(b * 128 + c) * 768 + ch] = H;
    }
    __syncthreads();
  }
}
__device__ __forceinline__ void rglru_2(const Params& p, int item) {
  unsigned char* ws = p.ws;
  const int tid = tidx_();
  const int b = item >> 7, c = item & 127;
  const int t0 = b * SEQ + c * 32;
  const u16* Z = (const u16*)(ws + OFF_Z);
  const float* PA = (const float*)(ws + OFF_SCR); const float* HU = (const float*)(ws + OFF_SCR + 48 * MiB);
  const float* sumP = (const float*)(ws + M_SUMP); const float* sumH = (const float*)(ws + M_SUMH);
  u16* cat = (u16*)(ws + OFF_CAT);
  float H[3] = {0.f, 0.f, 0.f};
  for (int c0 = 0; c0 < c; c0 += 8) {
    float sp[3][8], sh[3][8];
#pragma unroll
    for (int k = 0; k < 3; ++k)
#pragma unroll
      for (int j = 0; j < 8; ++j) {
        const int c2 = (c0 + j < c) ? c0 + j : c0;
        const size_t o = (size_t)(b * 128 + c2) * 768 + tid + k * 256;
        sp[k][j] = sumP[o]; sh[k][j] = sumH[o];
      }
    __builtin_amdgcn_sched_barrier(0);
#pragma unroll
    for (int j = 0; j < 8; ++j)
      if (c0 + j < c) {
#pragma unroll
        for (int k = 0; k < 3; ++k) H[k] = sp[k][j] * H[k] + sh[k][j];
      }
  }
#pragma unroll 1
  for (int l0 = 0; l0 < 32; l0 += 8) {
    float hu[3][8], pa[3][8], gt[3][8];
#pragma unroll
    for (int k = 0; k < 3; ++k)
#pragma unroll
      for (int j = 0; j < 8; ++j) {
        const size_t t = (size_t)(t0 + l0 + j); const int ch = tid + k * 256;
        hu[k][j] = HU[t * 768 + ch]; pa[k][j] = PA[t * 768 + ch]; gt[k][j] = bf2f(Z[t * ZLD1 + ch]);
      }
    __builtin_amdgcn_sched_barrier(0);
#pragma unroll
    for (int k = 0; k < 3; ++k)
#pragma unroll
      for (int j = 0; j < 8; ++j) {
        const size_t t = (size_t)(t0 + l0 + j); const int ch = tid + k * 256;
        cat[t * 1024 + ch] = f2bf((hu[k][j] + pa[k][j] * H[k]) * geluf_(gt[k][j]));
      }
  }
}

__device__ __forceinline__ void peer_q_item(const Params& p, int layer, int item, unsigned char* smem) {
  unsigned char* ws = p.ws;
  const int tid = tidx_(), lane = tid & 63, w = tid >> 6, wm = w >> 1, wn = w & 1, r = lane & 31, h2 = lane >> 5;
  const int hd = item & 7, mt = item >> 3;
  const u16* xb = (const u16*)(ws + OFF_XB);
  const u16* Wt = (const u16*)(ws + W_Q) + (size_t)layer * 2048 * 1024;
  const u16* skf = (const u16*)(ws + W_SK) + (size_t)layer * 2 * 16384;
  float* TK = (float*)(ws + OFF_TK);
  u16* Qs = (u16*)smem;
  float* Sf = (float*)smem;
  float* tmp = (float*)(smem + 69632);
#pragma unroll 1
  for (int pp = 0; pp < 2; ++pp) {
    f32x16 acc[4][2];
    gemm_mainloop(xb, Wt, mt * 256, (hd * 2 + pp) * 128, (u16*)smem, acc);
    const u16* skp = skf + (size_t)pp * 16384 + (size_t)(wn * 2) * 8 * 512 + lane * 8;
    bf16x8 pb0[4], pb1[4];
#pragma unroll
    for (int k4 = 0; k4 < 4; ++k4) { pb0[k4] = gfrag(skp + k4 * 512); pb1[k4] = gfrag(skp + (8 + k4) * 512); }
    __builtin_amdgcn_sched_barrier(0);
#pragma unroll
    for (int i = 0; i < 4; ++i)
#pragma unroll
      for (int j = 0; j < 2; ++j)
#pragma unroll
        for (int reg = 0; reg < 16; ++reg) Qs[(wm * 128 + i * 32 + crow(reg, h2)) * 136 + wn * 64 + j * 32 + r] = f2bf(acc[i][j][reg]);
    __syncthreads();
#pragma unroll
    for (int i = 0; i < 4; ++i)
#pragma unroll
      for (int j = 0; j < 2; ++j) acc[i][j] = zero16();
#pragma unroll
    for (int kg = 0; kg < 2; ++kg) {
      bf16x8 b0[4], b1[4];
#pragma unroll
      for (int k4 = 0; k4 < 4; ++k4) {
        if (kg == 0) { b0[k4] = pb0[k4]; b1[k4] = pb1[k4]; }
        else { b0[k4] = gfrag(skp + (4 + k4) * 512); b1[k4] = gfrag(skp + (8 + 4 + k4) * 512); }
      }
      __builtin_amdgcn_sched_barrier(0);
#pragma unroll
      for (int k4 = 0; k4 < 4; ++k4) {
        const int kk = kg * 4 + k4;
#pragma unroll
        for (int i = 0; i < 4; ++i) {
          bf16x8 a = ldsfrag(Qs + (wm * 128 + i * 32 + r) * 136 + kk * 16 + h2 * 8);
          acc[i][0] = __builtin_amdgcn_mfma_f32_32x32x16_bf16(a, b0[k4], acc[i][0], 0, 0, 0);
          acc[i][1] = __builtin_amdgcn_mfma_f32_32x32x16_bf16(a, b1[k4], acc[i][1], 0, 0, 0);
        }
      }
    }
    __syncthreads();
#pragma unroll 1
    for (int hf = 0; hf < 2; ++hf) {
      if (wm == hf) {
#pragma unroll
        for (int i = 0; i < 4; ++i)
#pragma unroll
          for (int j = 0; j < 2; ++j)
#pragma unroll
            for (int reg = 0; reg < 16; ++reg) Sf[(i * 32 + crow(reg, h2)) * 129 + wn * 64 + j * 32 + r] = acc[i][j][reg];
      }
      __syncthreads();
      {
        int row = tid & 127, half = tid >> 7;
        float s[16];
#pragma unroll
        for (int i = 0; i < 16; ++i) s[i] = -3.0e38f;
#pragma unroll 4
        for (int j = 0; j < 64; ++j) {
          int key = half * 64 + j;
          float v = Sf[row * 129 + key];
          v = __uint_as_float((__float_as_uint(v) & ~127u) | (unsigned)key);
          ins16(s, v);
        }
        if (half == 1) {
#pragma unroll
          for (int i = 0; i < 16; ++i) tmp[row * 17 + i] = s[i];
        }
        __syncthreads();
        if (half == 0) {
#pragma unroll
          for (int i = 0; i < 16; ++i) ins16(s, tmp[row * 17 + i]);
          float* dst = TK + ((size_t)(mt * 256 + hf * 128 + row) * 8 + hd) * 32 + pp * 16;
#pragma unroll
          for (int i = 0; i < 4; ++i) *reinterpret_cast<float4*>(dst + i * 4) = make_float4(s[i * 4], s[i * 4 + 1], s[i * 4 + 2], s[i * 4 + 3]);
        }
      }
      __syncthreads();
    }
  }
  __syncthreads();
  {
    const size_t tok = (size_t)mt * 256 + tid;
    const float* tk = TK + (tok * 8 + hd) * 32;
    float f0[16], f1[16], s[16];
#pragma unroll
    for (int i = 0; i < 4; ++i) {
      float4 a = *reinterpret_cast<const float4*>(tk + i * 4), b = *reinterpret_cast<const float4*>(tk + 16 + i * 4);
      f0[i * 4] = a.x; f0[i * 4 + 1] = a.y; f0[i * 4 + 2] = a.z; f0[i * 4 + 3] = a.w;
      f1[i * 4] = b.x; f1[i * 4 + 1] = b.y; f1[i * 4 + 2] = b.z; f1[i * 4 + 3] = b.w;
    }
#pragma unroll
    for (int i = 0; i < 16; ++i) s[i] = -3.0e38f;
#pragma unroll
    for (int i = 0; i < 16; ++i)
#pragma unroll
      for (int j = 0; j < 16; ++j)
        if ((i + 1) * (j + 1) <= 16) {
          float v = f0[i] + f1[j];
          v = __uint_as_float((__float_as_uint(v) & ~255u) | (unsigned)(i * 16 + j));
          ins16(s, v);
        }
    float e[16], sum = 0.f;
#pragma unroll
    for (int k = 0; k < 16; ++k) { e[k] = __expf(s[k] - s[0]); sum += e[k]; }
    float inv = 1.f / sum;
    int* se = (int*)(ws + OFF_SEL) + tok * 128 + hd * 16;
    float* sg = (float*)(ws + OFF_SEL + 8 * MiB) + tok * 128 + hd * 16;
    const unsigned* tku = reinterpret_cast<const unsigned*>(tk);
    unsigned i0v[16], i1v[16];
#pragma unroll
    for (int k = 0; k < 16; ++k) {
      unsigned code = __float_as_uint(s[k]) & 255u;
      i0v[k] = tku[code >> 4]; i1v[k] = tku[16 + (code & 15u)];
    }
    __builtin_amdgcn_sched_barrier(0);
#pragma unroll
    for (int k4 = 0; k4 < 4; ++k4) {
      int4 ev; float4 gv;
      ev.x = (int)((i0v[k4 * 4] & 127u) * 128u + (i1v[k4 * 4] & 127u)); ev.y = (int)((i0v[k4 * 4 + 1] & 127u) * 128u + (i1v[k4 * 4 + 1] & 127u));
      ev.z = (int)((i0v[k4 * 4 + 2] & 127u) * 128u + (i1v[k4 * 4 + 2] & 127u)); ev.w = (int)((i0v[k4 * 4 + 3] & 127u) * 128u + (i1v[k4 * 4 + 3] & 127u));
      gv.x = e[k4 * 4] * inv; gv.y = e[k4 * 4 + 1] * inv; gv.z = e[k4 * 4 + 2] * inv; gv.w = e[k4 * 4 + 3] * inv;
      *reinterpret_cast<int4*>(se + k4 * 4) = ev;
      *reinterpret_cast<float4*>(sg + k4 * 4) = gv;
    }
  }
}

typedef float f2v_ __attribute__((ext_vector_type(2)));
#define FP8_DOT4P(W, XA, XB, ACC2) do { f2v_ lo_ = __builtin_amdgcn_cvt_pk_f32_fp8((int)(W), false); f2v_ hi_ = __builtin_amdgcn_cvt_pk_f32_fp8((int)(W), true); \
    ACC2 = __builtin_elementwise_fma(lo_, XA, ACC2); ACC2 = __builtin_elementwise_fma(hi_, XB, ACC2); } while (0)
#define FP8_AXPY4P(W, CF2, YA, YB) do { f2v_ lo_ = __builtin_amdgcn_cvt_pk_f32_fp8((int)(W), false); f2v_ hi_ = __builtin_amdgcn_cvt_pk_f32_fp8((int)(W), true); \
    YA = __builtin_elementwise_fma(lo_, CF2, YA); YB = __builtin_elementwise_fma(hi_, CF2, YB); } while (0)
__device__ __forceinline__ void phase_peer_experts(const Params& p, int layer) {
  unsigned char* ws = p.ws;
  const int lane = tidx_() & 63, w = tidx_() >> 6;
  const float* pre = (const float*)(ws + OFF_Z);
  const unsigned char* ub = ws + OFF_TAB + (size_t)(layer * 2) * 16384 * 1024;
  const unsigned char* vb = ub + (size_t)16384 * 1024;
  const float* usc = (const float*)(ws + M_TSC) + (size_t)(layer * 2) * 16384;
  const float* vsc = usc + 16384;
  const int* se = (const int*)(ws + OFF_SEL); const float* sg = (const float*)(ws + OFF_SEL + 8 * MiB);
  const float* g1 = p.in[15] + layer * 1024; const float* b1 = p.in[16] + layer * 1024;
  const float* g2 = p.in[21] + layer * 1024; const float* b2 = p.in[22] + layer * 1024;
  u16* xb = (u16*)(ws + OFF_XB);
  float* xo = p.out;
  const int e0 = lane * 16;
  for (int tok = blockIdx.x * 4 + w; tok < T_TOK; tok += gridDim.x * 4) {
    float x[16];
    {
      const float* pr = pre + (size_t)tok * 1024 + e0;
      float4 a = *reinterpret_cast<const float4*>(pr), b = *reinterpret_cast<const float4*>(pr + 4);
      float4 c = *reinterpret_cast<const float4*>(pr + 8), d = *reinterpret_cast<const float4*>(pr + 12);
      x[0] = a.x; x[1] = a.y; x[2] = a.z; x[3] = a.w; x[4] = b.x; x[5] = b.y; x[6] = b.z; x[7] = b.w;
      x[8] = c.x; x[9] = c.y; x[10] = c.z; x[11] = c.w; x[12] = d.x; x[13] = d.y; x[14] = d.z; x[15] = d.w;
      float s = 0.f;
#pragma unroll
      for (int i = 0; i < 16; ++i) s += x[i];
      float mu = wsum(s) * (1.f / 1024.f);
      float q = 0.f;
#pragma unroll
      for (int i = 0; i < 16; ++i) { float t = x[i] - mu; q += t * t; }
      float rstd = rsqrtf(wsum(q) * (1.f / 1024.f) + LN_EPS);
#pragma unroll
      for (int i = 0; i < 16; ++i) x[i] = (x[i] - mu) * rstd * g1[e0 + i] + b1[e0 + i];
    }
    int eA = se[(size_t)tok * 128 + lane], eB = se[(size_t)tok * 128 + 64 + lane];
    float gA = sg[(size_t)tok * 128 + lane], gB = sg[(size_t)tok * 128 + 64 + lane];
    float uA = usc[eA], uB = usc[eB];
    gA *= vsc[eA]; gB *= vsc[eB];
    f2v_ x2[8], y2[8];
#pragma unroll
    for (int i = 0; i < 8; ++i) { x2[i].x = x[2 * i]; x2[i].y = x[2 * i + 1]; y2[i].x = 0.f; y2[i].y = 0.f; }
#pragma unroll 1
    for (int hsel = 0; hsel < 2; ++hsel) {
    const int eS = hsel ? eB : eA; const float gS = hsel ? gB : gA, uS = hsel ? uB : uA;
#pragma unroll 1
    for (int bt = 0; bt < 8; ++bt) {
      uint4 U[8], V[8];
#pragma unroll
      for (int k = 0; k < 8; ++k) {
        int idx = bt * 8 + k;
        int eid = __builtin_amdgcn_readlane(eS, idx);
        U[k] = *reinterpret_cast<const uint4*>(ub + (size_t)eid * 1024 + e0);
        V[k] = *reinterpret_cast<const uint4*>(vb + (size_t)eid * 1024 + e0);
      }
      float w1;
      {
        const bool b0 = (lane & 1) != 0, b1 = (lane & 2) != 0, b2 = (lane & 4) != 0;
        float d8[8];
#pragma unroll
        for (int k = 0; k < 8; ++k) {
          f2v_ d2; d2.x = 0.f; d2.y = 0.f;
          FP8_DOT4P(U[k].x, x2[0], x2[1], d2);
          FP8_DOT4P(U[k].y, x2[2], x2[3], d2);
          FP8_DOT4P(U[k].z, x2[4], x2[5], d2);
          FP8_DOT4P(U[k].w, x2[6], x2[7], d2);
          d8[k] = d2.x + d2.y;
        }
        float w4[4], w2[2];
#pragma unroll
        for (int m = 0; m < 4; ++m) { float keep = b0 ? d8[2 * m + 1] : d8[2 * m], send = b0 ? d8[2 * m] : d8[2 * m + 1]; w4[m] = keep + __shfl_xor(send, 1); }
#pragma unroll
        for (int m = 0; m < 2; ++m) { float keep = b1 ? w4[2 * m + 1] : w4[2 * m], send = b1 ? w4[2 * m] : w4[2 * m + 1]; w2[m] = keep + __shfl_xor(send, 2); }
        { float keep = b2 ? w2[1] : w2[0], send = b2 ? w2[0] : w2[1]; w1 = keep + __shfl_xor(send, 4); }
        w1 += __shfl_xor(w1, 8);
        w1 += __shfl_xor(w1, 16);
        w1 += __shfl_xor(w1, 32);
      }
      const float cfl = gS * geluf_(w1 * uS);
#pragma unroll
      for (int k = 0; k < 8; ++k) {
        float cf = __int_as_float(__builtin_amdgcn_readlane(__float_as_int(cfl), bt * 8 + k));
        f2v_ cf2; cf2.x = cf; cf2.y = cf;
        FP8_AXPY4P(V[k].x, cf2, y2[0], y2[1]);
        FP8_AXPY4P(V[k].y, cf2, y2[2], y2[3]);
        FP8_AXPY4P(V[k].z, cf2, y2[4], y2[5]);
        FP8_AXPY4P(V[k].w, cf2, y2[6], y2[7]);
      }
    }
    }
    {
      float y[16];
#pragma unroll
      for (int i = 0; i < 8; ++i) { y[2 * i] = y2[i].x; y[2 * i + 1] = y2[i].y; }
      float s = 0.f;
#pragma unroll
      for (int i = 0; i < 16; ++i) { y[i] = DN_ALPHA * x[i] + y[i]; s += y[i]; }
      float mu = wsum(s) * (1.f / 1024.f);
      float q = 0.f;
#pragma unroll
      for (int i = 0; i < 16; ++i) { float t = y[i] - mu; q += t * t; }
      float rstd = rsqrtf(wsum(q) * (1.f / 1024.f) + LN_EPS);
#pragma unroll
      for (int i = 0; i < 16; ++i) y[i] = (y[i] - mu) * rstd * g2[e0 + i] + b2[e0 + i];
      float* po = xo + (size_t)tok * 1024 + e0;
      *reinterpret_cast<float4*>(po) = make_float4(y[0], y[1], y[2], y[3]);
      *reinterpret_cast<float4*>(po + 4) = make_float4(y[4], y[5], y[6], y[7]);
      *reinterpret_cast<float4*>(po + 8) = make_float4(y[8], y[9], y[10], y[11]);
      *reinterpret_cast<float4*>(po + 12) = make_float4(y[12], y[13], y[14], y[15]);
      u16* pb = xb + (size_t)tok * 1024 + e0;
      uint4 o0, o1;
      o0.x = pack2(y[0], y[1]); o0.y = pack2(y[2], y[3]); o0.z = pack2(y[4], y[5]); o0.w = pack2(y[6], y[7]);
      o1.x = pack2(y[8], y[9]); o1.y = pack2(y[10], y[11]); o1.z = pack2(y[12], y[13]); o1.w = pack2(y[14], y[15]);
      *reinterpret_cast<uint4*>(pb) = o0; *reinterpret_cast<uint4*>(pb + 8) = o1;
    }
  }
}

#define XB_TMO      128
#define XB_XCNT(j)  (256  + 64 * (j))
#define XB_XSUB(j)  (1280 + 64 * (j))
#define XB_XGEN(j)  (2304 + 64 * (j))
#define XB_TOP      3328
#define XB_TOPGEN   3392
#define XCD_BAR_WORDS 3456
#define XB_SPIN_CAP (1u << 18)
__device__ __forceinline__ unsigned xb_ld(unsigned* p)              { return __hip_atomic_load(p, __ATOMIC_RELAXED, __HIP_MEMORY_SCOPE_AGENT); }
__device__ __forceinline__ unsigned xb_add(unsigned* p, unsigned v) { return __hip_atomic_fetch_add(p, v, __ATOMIC_RELAXED, __HIP_MEMORY_SCOPE_AGENT); }
__device__ __forceinline__ unsigned xb_xcc_id() { return (unsigned)__builtin_amdgcn_s_getreg((3 << 11) | 20) & 0xFu; }
#define XB_SPIN(cond, bar) do { unsigned _sp = 0; while (cond) { __builtin_amdgcn_s_sleep(1); \
    if ((++_sp & 255u) == 0u) { if (xb_ld(&(bar)[XB_TMO])) break; if (_sp > XB_SPIN_CAP) { atomicAdd(&(bar)[XB_TMO], 1u); break; } } } } while (0)
struct XcdBarrier { unsigned* bar; unsigned x; volatile LAS unsigned* st; };
__device__ __forceinline__ XcdBarrier xcd_barrier_post(unsigned* bar, volatile LAS unsigned* st) {
    XcdBarrier b; b.bar = bar; b.x = xb_xcc_id(); b.st = st;
    if (tidx_() == 0) (void)xb_add(&bar[XB_XCNT(b.x)], 1u);
    return b;
}
__device__ __forceinline__ void xcd_barrier_complete(unsigned* bar, unsigned x, unsigned& nloc, unsigned& nx) {
    const unsigned G = gridDim.x * gridDim.y * gridDim.z;
    unsigned sum, cnt, mine, sp = 0u;
    for (;;) {
        sum = 0u; cnt = 0u; mine = 0u;
#pragma unroll
        for (unsigned j = 0; j < 16; ++j) { const unsigned c = xb_ld(&bar[XB_XCNT(j)]); sum += c; cnt += (c > 0u) ? 1u : 0u; mine = (j == x) ? c : mine; }
        if (sum == G) break;
        __builtin_amdgcn_s_sleep(1);
        if ((++sp & 255u) == 0u) { if (xb_ld(&bar[XB_TMO])) break; if (sp > XB_SPIN_CAP) { atomicAdd(&bar[XB_TMO], 1u); break; } }
    }
    nloc = mine > 0u ? mine : 1u; nx = cnt > 0u ? cnt : 1u;
}
__device__ __forceinline__ void xcd_barrier(const XcdBarrier& b) {
    asm volatile("s_waitcnt vmcnt(0)" ::: "memory");
    __syncthreads();
    if (tidx_() == 0) {
        unsigned* bar = b.bar;
        __builtin_amdgcn_s_waitcnt(0);
        unsigned nloc = b.st[0], nx = b.st[1];
        if (nloc == 0u) { xcd_barrier_complete(bar, b.x, nloc, nx); b.st[0] = nloc; b.st[1] = nx; }
        const unsigned old = xb_add(&bar[XB_XSUB(b.x)], 1u);
        const unsigned gen = old / nloc;
        if (old + 1u == (gen + 1u) * nloc) {
            __builtin_amdgcn_fence(__ATOMIC_RELEASE, "agent");
            asm volatile("s_waitcnt vmcnt(0)" ::: "memory");
            const unsigned og = xb_add(&bar[XB_TOP], 1u);
            const unsigned tg = og / nx;
            if (og + 1u == (tg + 1u) * nx) xb_add(&bar[XB_TOPGEN], 1u);
            else XB_SPIN(xb_ld(&bar[XB_TOPGEN]) == tg, bar);
            __builtin_amdgcn_fence(__ATOMIC_ACQUIRE, "agent");
            xb_add(&bar[XB_XGEN(b.x)], 1u);
            asm volatile("s_waitcnt vmcnt(0)" ::: "memory");
        } else {
            XB_SPIN(xb_ld(&bar[XB_XGEN(b.x)]) == gen, bar);
            __builtin_amdgcn_fence(__ATOMIC_ACQUIRE, "agent");
            asm volatile("s_waitcnt vmcnt(0)" ::: "memory");
        }
    }
    __syncthreads();
}

constexpr int N_PHASES = 16;
__device__ __forceinline__ void run_phase(const Params& p, const int ph, unsigned char* smem) {
  const int bid = blockIdx.x, nb = gridDim.x;
  switch (ph) {
    case 0: phase_prep(p); break;
    case 1: phase_inproj(p, 0, smem); break;
    case 2: for (int it = bid; it < 1024; it += nb) mlstm_A(p, it, smem); break;
    case 3: {
      phase_mlstm_scan(p);
      if (nb == 512) {
        if (bid < 288) { xattn_item(p, 0, bid * 2, smem); xattn_item(p, 0, bid * 2 + 1, smem); }
        else for (int it = 576 + (bid - 288); it < 2048; it += 224) xattn_item(p, 0, it, smem);
      } else {
        for (int it = bid; it < 2048; it += nb) xattn_item(p, 0, it, smem);
      }
    } break;
    case 4: for (int it = bid; it < 2048; it += nb) mlstm_C(p, it, smem); break;
    case 5: phase_outproj(p, 0, smem); break;
    case 6: phase_ln1(p, 0); break;
    case 7: for (int rd = 0; rd < (512 + nb - 1) / nb; ++rd) { int mt, hd; if (xcd_tile(rd, 8, 512, mt, hd)) peer_q_item(p, 0, mt * 8 + hd, smem); } break;
    case 8: phase_peer_experts(p, 0); break;
    case 9: phase_inproj(p, 1, smem); break;
    case 10:
      for (int it = bid; it < 512 + 2048; it += nb) { if (it < 512) rglru_1(p, it, smem); else xattn_item(p, 1, it - 512, smem); }
      break;
    case 11: for (int it = bid; it < 512; it += nb) rglru_2(p, it); break;
    case 12: phase_outproj(p, 1, smem); break;
    case 13: phase_ln1(p, 1); break;
    case 14: for (int rd = 0; rd < (512 + nb - 1) / nb; ++rd) { int mt, hd; if (xcd_tile(rd, 8, 512, mt, hd)) peer_q_item(p, 1, mt * 8 + hd, smem); } break;
    case 15: phase_peer_experts(p, 1); break;
    default: break;
  }
}

template <int PH>
__global__ void __launch_bounds__(256, 2) phase_kernel(Params p) {
  __shared__ __attribute__((aligned(16))) unsigned char smem[SMEM_BYTES];
  run_phase(p, PH, smem);
}

#define SEAM() xcd_barrier(xb)
#ifndef DUP_MASK
#define DUP_MASK 0
#endif
#define RUN(N) do { run_phase(p, N, smem); if (DUP_MASK & (1 << (N))) { SEAM(); run_phase(p, N, smem); } } while (0)
__global__ void __launch_bounds__(256, 2) fwd_megakernel(Params p) {
  __shared__ __attribute__((aligned(16))) unsigned char smem[SMEM_BYTES + 16];
  cg::grid_group grid = cg::this_grid();
  if (tidx_() == 0) *reinterpret_cast<uint4*>(smem + SMEM_BYTES) = make_uint4(0u, 0u, 0u, 0u);
  __syncthreads();
  XcdBarrier xb = xcd_barrier_post((unsigned*)(p.ws + M_BAR), (volatile LAS unsigned*)(smem + SMEM_BYTES));
  if (p.ph_lo < 0) grid.sync();
  run_phase(p, 0, smem); if (DUP_MASK & 1) { SEAM(); run_phase(p, 0, smem); } SEAM();
  RUN(1); SEAM();
  RUN(2); SEAM();
  RUN(3); SEAM();
  RUN(4); SEAM();
  RUN(5); SEAM();
  RUN(6); SEAM();
  RUN(7); SEAM();
  RUN(8); SEAM();
  RUN(9); SEAM();
  RUN(10); SEAM();
  RUN(11); SEAM();
  RUN(12); SEAM();
  RUN(13); SEAM();
  RUN(14); SEAM();
  RUN(15);
}

extern "C" void kernel_launch(void* const* d_in, const int* in_sizes, int n_in, void* d_out, int out_size, void* d_ws, size_t ws_size,
                              hipStream_t stream) {
  if (n_in != 23 || out_size != T_TOK * DM || ws_size < WS_NEED) {
    fprintf(stderr, "kernel_launch: unexpected shapes (n_in %d, out %d, ws %zu); nothing launched\n", n_in, out_size, ws_size);
    return;
  }
  Params p{};
  for (int i = 0; i < 23; ++i) p.in[i] = (const float*)d_in[i];
  p.out = (float*)d_out; p.ws = (unsigned char*)d_ws;
#if MK_COOP
  static int grid_blocks = 0;
  if (!grid_blocks) {
    int dev = 0, cus = 0, per_cu = 0;
    hipGetDevice(&dev);
    hipDeviceGetAttribute(&cus, hipDeviceAttributeMultiprocessorCount, dev);
    hipOccupancyMaxActiveBlocksPerMultiprocessor(&per_cu, fwd_megakernel, 256, 0);
    if (per_cu > 2) per_cu = 2;
    if (per_cu < 1) per_cu = 1;
    grid_blocks = cus * per_cu;
  }
  p.ph_lo = 0; p.ph_hi = N_PHASES;
  hipMemsetAsync((unsigned char*)d_ws + M_BAR, 0, XCD_BAR_WORDS * 4, stream);
  void* args[] = {&p};
  hipError_t e = hipLaunchCooperativeKernel((void*)fwd_megakernel, dim3(grid_blocks), dim3(256), args, 0, stream);
  if (e != hipSuccess) fprintf(stderr, "cooperative launch failed: %s (grid %d)\n", hipGetErrorString(e), grid_blocks);
#else
#define LPH(N) hipLaunchKernelGGL(phase_kernel<N>, dim3(512), dim3(256), 0, stream, p)
  LPH(0); LPH(1); LPH(2); LPH(3); LPH(4); LPH(5); LPH(6); LPH(7);
  LPH(8); LPH(9); LPH(10); LPH(11); LPH(12); LPH(13); LPH(14); LPH(15);
#undef LPH
#endif
}
```

```cpp
#include <hip/hip_runtime.h>
#include <hip/hip_cooperative_groups.h>
#include <cstdio>
#include <cstdint>
namespace cg = cooperative_groups;

#ifndef MK_COOP
#define MK_COOP 1
#endif

#define LAS __attribute__((address_space(3)))
typedef unsigned short u16;
typedef unsigned int u32x4 __attribute__((ext_vector_type(4)));
__device__ __forceinline__ int tidx_() { int t = threadIdx.x; asm volatile("" : "+v"(t)); return t; }
typedef float f32x4v __attribute__((ext_vector_type(4)));
typedef __attribute__((ext_vector_type(8))) short bf16x8;
typedef __attribute__((ext_vector_type(16))) float f32x16;

constexpr int T_TOK = 16384, DM = 1024, SEQ = 4096;
constexpr int ZLD0 = 3328, ZLD1 = 1792;
constexpr float DN_ALPHA = 1.41421356237f;
constexpr float LN_EPS = 1e-5f;
constexpr size_t MiB = 1024 * 1024;

constexpr size_t OFF_TAB  = 0;
constexpr size_t OFF_Z    = 128 * MiB;
constexpr size_t OFF_SCR  = 232 * MiB;
constexpr size_t OFF_XB   = 376 * MiB;
constexpr size_t OFF_CAT  = 408 * MiB;
constexpr size_t OFF_TK   = 440 * MiB;
constexpr size_t OFF_SEL  = 456 * MiB;
constexpr size_t OFF_W    = 472 * MiB;
constexpr size_t OFF_MISC = 500 * MiB;
constexpr size_t WS_NEED  = 508 * MiB;
constexpr size_t W_IN0  = OFF_W;
constexpr size_t W_IN1  = W_IN0 + 7 * MiB;
constexpr size_t W_OUT  = W_IN1 + 4 * MiB;
constexpr size_t W_Q    = W_OUT + 4 * MiB;
constexpr size_t W_KV   = W_Q + 8 * MiB;
constexpr size_t W_MEM  = W_KV + 2 * MiB;
constexpr size_t W_SK   = W_MEM + 2 * MiB;
constexpr size_t W_AF   = W_SK + 128 * 1024;
constexpr size_t M_GATES = OFF_MISC;
constexpr size_t M_STBL  = M_GATES + 512 * 1024;
constexpr size_t M_STML  = M_STBL + 4096;
constexpr size_t M_MIN   = M_STML + 4096;
constexpr size_t M_NLOC  = M_MIN + 4096;
constexpr size_t M_NIN   = M_NLOC + 768 * 1024;
constexpr size_t M_KF    = M_NIN + 768 * 1024;
constexpr size_t M_VF    = M_KF + 1024 * 1024;
constexpr size_t M_SUMP  = M_VF + 1024 * 1024;
constexpr size_t M_SUMH  = M_SUMP + 1536 * 1024;
constexpr size_t M_BAR   = M_SUMH + 1536 * 1024;
constexpr size_t M_TSC   = M_BAR + 16 * 1024;

struct Params {
  const float* in[23];
  float* out;
  unsigned char* ws;
  int ph_lo, ph_hi;
};

constexpr int SMEM_BYTES = 79872;
constexpr int BKP = 72;

typedef float f2cv_ __attribute__((ext_vector_type(2)));
typedef __bf16 bf2cv_ __attribute__((ext_vector_type(2)));
__device__ __forceinline__ u16 f2bf(float f) { __bf16 s = (__bf16)f; return __builtin_bit_cast(u16, s); }
__device__ __forceinline__ float bf2f(u16 h) { return __uint_as_float(((unsigned)h) << 16); }
__device__ __forceinline__ unsigned pack2(float a, float b) { f2cv_ v; v.x = a; v.y = b; bf2cv_ r = __builtin_convertvector(v, bf2cv_); return __builtin_bit_cast(unsigned, r); }
__device__ __forceinline__ float bflo(unsigned w) { return __uint_as_float(w << 16); }
__device__ __forceinline__ float bfhi(unsigned w) { return __uint_as_float(w & 0xffff0000u); }
__device__ __forceinline__ float sigmoidf_(float x) { return 1.f / (1.f + __expf(-x)); }
__device__ __forceinline__ float logsigmoidf_(float x) { return fminf(x, 0.f) - log1pf(expf(-fabsf(x))); }
__device__ __forceinline__ float softplusf_(float x) { return fmaxf(x, 0.f) + log1pf(expf(-fabsf(x))); }
__device__ __forceinline__ float erf_as_(float x) {
  const float ax = fabsf(x);
  const float t = __builtin_amdgcn_rcpf(1.f + 0.3275911f * ax);
  const float poly = t * (0.254829592f + t * (-0.284496736f + t * (1.421413741f + t * (-1.453152027f + t * 1.061405429f))));
  const float r = 1.f - poly * __expf(-ax * ax);
  return copysignf(r, x);
}
__device__ __forceinline__ float geluf_(float x) { return 0.5f * x * (1.f + erf_as_(x * 0.70710678118654752f)); }
__device__ __forceinline__ float wsum(float v) {
#pragma unroll
  for (int o = 32; o > 0; o >>= 1) v += __shfl_xor(v, o);
  return v;
}
__device__ __forceinline__ float wmax(float v) {
#pragma unroll
  for (int o = 32; o > 0; o >>= 1) v = fmaxf(v, __shfl_xor(v, o));
  return v;
}
__device__ __forceinline__ int crow(int reg, int h) { return (reg & 3) + 8 * (reg >> 2) + 4 * h; }
__device__ __forceinline__ f32x16 zero16() {
  f32x16 z;
#pragma unroll
  for (int i = 0; i < 16; ++i) z[i] = 0.f;
  return z;
}
__device__ __forceinline__ bf16x8 ldsfrag(const u16* p) { return *reinterpret_cast<const bf16x8*>(p); }
__device__ __forceinline__ bf16x8 gfrag(const u16* p) { return *reinterpret_cast<const bf16x8*>(p); }
__device__ __forceinline__ bf16x8 ldsfrag_strided(const u16* p, int stride) {
  bf16x8 f;
#pragma unroll
  for (int j = 0; j < 8; ++j) f[j] = (short)p[j * stride];
  return f;
}
__device__ __forceinline__ void ins16(float (&s)[16], float x) {
#pragma unroll
  for (int i = 15; i >= 1; --i) s[i] = __builtin_amdgcn_fmed3f(s[i - 1], s[i], x);
  s[0] = __builtin_amdgcn_fmed3f(__builtin_inff(), s[0], x);
}

__device__ __forceinline__ void gemm_mainloop(const u16* __restrict__ A, const u16* __restrict__ Bt, int m0, int n0,
                                              u16* lds, f32x16 (&acc)[4][2]) {
  const int tid = tidx_(), lane = tid & 63, w = tid >> 6, wm = w >> 1, wn = w & 1, r = lane & 31, h = lane >> 5;
#pragma unroll
  for (int i = 0; i < 4; ++i)
#pragma unroll
    for (int j = 0; j < 2; ++j) acc[i][j] = zero16();
  unsigned char* ldsb = (unsigned char*)lds;
  const int skc = (lane & 3) ^ ((lane >> 4) & 3);
  const u16* Ag = A + (size_t)(m0 + w * 16 + (lane >> 2)) * 1024 + skc * 8;
  const u16* Bg = Bt + (size_t)(n0 + w * 16 + (lane >> 2)) * 1024 + skc * 8;
  const int sw = (r >> 2) & 3;
  const int aoff = (wm * 128 + r) * 64;
  const int boff = 16384 + (wn * 64 + r) * 64;
#define GLDS_STAGE(BUF, KT) do { \
    _Pragma("unroll") \
    for (int i_ = 0; i_ < 4; ++i_) \
      __builtin_amdgcn_global_load_lds((const unsigned*)(Ag + (size_t)i_ * 64 * 1024 + (KT) * 32), (LAS unsigned*)(ldsb + (BUF) * 24576 + (i_ * 4 + w) * 1024), 16, 0, 0); \
    _Pragma("unroll") \
    for (int i_ = 0; i_ < 2; ++i_) \
      __builtin_amdgcn_global_load_lds((const unsigned*)(Bg + (size_t)i_ * 64 * 1024 + (KT) * 32), (LAS unsigned*)(ldsb + (BUF) * 24576 + 16384 + (i_ * 4 + w) * 1024), 16, 0, 0); \
    } while (0)
#define KSTEP(KT, CUR, NXT2, ISSUE) do { \
    if (ISSUE) GLDS_STAGE(NXT2, (KT) + 2); \
    const unsigned char* Bf_ = ldsb + (CUR) * 24576; \
    _Pragma("unroll") \
    for (int kk = 0; kk < 2; ++kk) { \
      const int c_ = ((kk * 2 + h) ^ sw) << 4; \
      bf16x8 b0 = *reinterpret_cast<const bf16x8*>(Bf_ + boff + c_); \
      bf16x8 b1 = *reinterpret_cast<const bf16x8*>(Bf_ + boff + 2048 + c_); \
      _Pragma("unroll") \
      for (int i_ = 0; i_ < 4; ++i_) { \
        bf16x8 a_ = *reinterpret_cast<const bf16x8*>(Bf_ + aoff + i_ * 2048 + c_); \
        acc[i_][0] = __builtin_amdgcn_mfma_f32_32x32x16_bf16(a_, b0, acc[i_][0], 0, 0, 0); \
        acc[i_][1] = __builtin_amdgcn_mfma_f32_32x32x16_bf16(a_, b1, acc[i_][1], 0, 0, 0); \
      } \
    } \
    if (ISSUE) asm volatile("s_waitcnt vmcnt(6)" ::: "memory"); else asm volatile("s_waitcnt vmcnt(0)" ::: "memory"); \
    asm volatile("s_waitcnt lgkmcnt(0)" ::: "memory"); \
    __builtin_amdgcn_s_barrier(); } while (0)
  asm volatile("s_waitcnt vmcnt(0)" ::: "memory");
  __syncthreads();
  GLDS_STAGE(0, 0);
  GLDS_STAGE(1, 1);
  asm volatile("s_waitcnt vmcnt(6)" ::: "memory");
  asm volatile("s_waitcnt lgkmcnt(0)" ::: "memory");
  __builtin_amdgcn_s_barrier();
  int cur = 0, nx2 = 2;
#pragma unroll 1
  for (int kt = 0; kt < 32; ++kt) {
    KSTEP(kt, cur, nx2, (kt + 2 < 32));
    cur = (cur == 2) ? 0 : cur + 1;
    nx2 = (nx2 == 2) ? 0 : nx2 + 1;
  }
#undef KSTEP
#undef GLDS_STAGE
}

__device__ __forceinline__ int xcd_idx(int round) {
  const int b = blockIdx.x, G = gridDim.x;
  if ((G & 511) == 0) return ((round * (G >> 6) + ((b & 7) * (G >> 9)) + ((b >> 3) / 64)) * 64) + ((b >> 3) & 63);
  return round * G + b;
}
__device__ __forceinline__ bool xcd_tile(int round, int NT, int ntiles, int& mt, int& nt) {
  const int b = blockIdx.x, G = gridDim.x;
  int idx;
  if ((G & 511) == 0) { idx = ((round * (G >> 6) + ((b & 7) * (G >> 9)) + ((b >> 3) / 64)) * 64) + ((b >> 3) & 63); }
  else idx = round * G + b;
  if (idx >= ntiles) return false;
  int band = idx / (8 * NT), rem = idx % (8 * NT);
  nt = rem >> 3; mt = band * 8 + (rem & 7);
  return true;
}

__device__ __forceinline__ void cvt8(const float* __restrict__ s, u16* __restrict__ d) {
  float4 a = *reinterpret_cast<const float4*>(s), b = *reinterpret_cast<const float4*>(s + 4);
  uint4 o; o.x = pack2(a.x, a.y); o.y = pack2(a.z, a.w); o.z = pack2(b.x, b.y); o.w = pack2(b.z, b.w);
  *reinterpret_cast<uint4*>(d) = o;
}
__device__ __forceinline__ void transpose_w(const float* __restrict__ W, int N, int Npad, u16* __restrict__ Wt, int srcmap, size_t gtid, size_t gsz) {
  const size_t total = (size_t)Npad * 128;
  for (size_t id = gtid; id < total; id += gsz) {
    int n = (int)(id % Npad), kc = (int)(id / Npad);
    int src = n;
    if (srcmap == 1) { src = (n < 3072) ? n : (n < 3328 ? n + 8 : (n < 3336 ? n - 256 : -1)); }
    else if (n >= N) src = -1;
    float v[8];
#pragma unroll
    for (int j = 0; j < 8; ++j) v[j] = (src >= 0) ? W[(size_t)(kc * 8 + j) * N + src] : 0.f;
    uint4 o; o.x = pack2(v[0], v[1]); o.y = pack2(v[2], v[3]); o.z = pack2(v[4], v[5]); o.w = pack2(v[6], v[7]);
    *reinterpret_cast<uint4*>(Wt + (size_t)n * 1024 + kc * 8) = o;
  }
}
__device__ __forceinline__ void table_piece(const Params& p, int layer, int piece) {
  unsigned char* ws = p.ws;
  unsigned char* tab = ws + OFF_TAB;
  float* tsc = (float*)(ws + M_TSC);
  const int lane = tidx_() & 63, w = tidx_() >> 6;
  f32x4v tv[4][4];
#pragma unroll
  for (int i = 0; i < 4; ++i) {
    const int rr = piece * 16 + w * 4 + i; const int uv = rr >> 14;
    const float* src = (uv ? p.in[20] : p.in[19]) + (size_t)layer * 16384 * 1024 + (size_t)(rr & 16383) * 1024 + lane * 16;
#pragma unroll
    for (int q = 0; q < 4; ++q) tv[i][q] = *reinterpret_cast<const f32x4v*>(src + q * 4);
  }
  __builtin_amdgcn_sched_barrier(0);
#pragma unroll
  for (int i = 0; i < 4; ++i) {
    const int rr = piece * 16 + w * 4 + i;
    const size_t row = (size_t)layer * 32768 + rr;
    const f32x4v a = tv[i][0], b = tv[i][1], c = tv[i][2], d = tv[i][3];
    float m = fmaxf(fmaxf(fmaxf(fabsf(a.x), fabsf(a.y)), fmaxf(fabsf(a.z), fabsf(a.w))), fmaxf(fmaxf(fabsf(b.x), fabsf(b.y)), fmaxf(fabsf(b.z), fabsf(b.w))));
    m = fmaxf(m, fmaxf(fmaxf(fmaxf(fabsf(c.x), fabsf(c.y)), fmaxf(fabsf(c.z), fabsf(c.w))), fmaxf(fmaxf(fabsf(d.x), fabsf(d.y)), fmaxf(fabsf(d.z), fabsf(d.w)))));
    m = wmax(m);
    float sc = (m > 0.f) ? 416.f / m : 1.f;
    u32x4 o;
    int w0 = __builtin_amdgcn_cvt_pk_fp8_f32(a.x * sc, a.y * sc, 0, false); w0 = __builtin_amdgcn_cvt_pk_fp8_f32(a.z * sc, a.w * sc, w0, true);
    int w1 = __builtin_amdgcn_cvt_pk_fp8_f32(b.x * sc, b.y * sc, 0, false); w1 = __builtin_amdgcn_cvt_pk_fp8_f32(b.z * sc, b.w * sc, w1, true);
    int w2 = __builtin_amdgcn_cvt_pk_fp8_f32(c.x * sc, c.y * sc, 0, false); w2 = __builtin_amdgcn_cvt_pk_fp8_f32(c.z * sc, c.w * sc, w2, true);
    int w3 = __builtin_amdgcn_cvt_pk_fp8_f32(d.x * sc, d.y * sc, 0, false); w3 = __builtin_amdgcn_cvt_pk_fp8_f32(d.z * sc, d.w * sc, w3, true);
    o.x = (unsigned)w0; o.y = (unsigned)w1; o.z = (unsigned)w2; o.w = (unsigned)w3;
    *reinterpret_cast<u32x4*>(tab + row * 1024 + lane * 16) = o;
    if (lane == 0) tsc[row] = (m > 0.f) ? m / 416.f : 1.f;
  }
}
__device__ __forceinline__ void phase_prep(const Params& p) {
  const size_t gtid = (size_t)blockIdx.x * 256 + tidx_(), gsz = (size_t)gridDim.x * 256;
  unsigned char* ws = p.ws;
  {
    u16* xb = (u16*)(ws + OFF_XB);
    for (size_t g = gtid; g < (size_t)T_TOK * DM / 8; g += gsz) cvt8(p.in[0] + g * 8, xb + g * 8);
  }
  {
    u16* mb = (u16*)(ws + W_MEM);
    for (size_t g = gtid; g < (size_t)1024 * 1024 / 8; g += gsz) cvt8(p.in[1] + g * 8, mb + g * 8);
  }
  {
    u16* sk = (u16*)(ws + W_SK);
    for (size_t id = gtid; id < (size_t)2 * 2 * 4 * 8 * 64; id += gsz) {
      int lane = (int)(id & 63); int q = (int)(id >> 6);
      int ks = q & 7; q >>= 3; int kt = q & 3; q >>= 2;
      cvt8(p.in[18] + ((size_t)q * 128 + kt * 32 + (lane & 31)) * 128 + ks * 16 + 8 * (lane >> 5), sk + id * 8);
    }
  }
  transpose_w(p.in[2], 3336, 3456, (u16*)(ws + W_IN0), 1, gtid, gsz);
  transpose_w(p.in[5], 1792, 1792, (u16*)(ws + W_IN1), 0, gtid, gsz);
  for (int l = 0; l < 2; ++l) {
    transpose_w(p.in[14] + (size_t)l * 1024 * 1024, 1024, 1024, (u16*)(ws + W_OUT) + (size_t)l * 1024 * 1024, 0, gtid, gsz);
    transpose_w(p.in[17] + (size_t)l * 1024 * 2048, 2048, 2048, (u16*)(ws + W_Q) + (size_t)l * 2048 * 1024, 0, gtid, gsz);
    transpose_w(p.in[13] + (size_t)l * 1024 * 512, 512, 512, (u16*)(ws + W_KV) + (size_t)l * 512 * 1024, 0, gtid, gsz);
  }
  {
    u16* wf = (u16*)(ws + W_AF);
    for (size_t id = gtid; id < (size_t)2 * 8 * 3 * 6 * 64; id += gsz) {
      int lane = (int)(id & 63); int q = (int)(id >> 6);
      int ks = q % 6; q /= 6; int jt = q % 3; q /= 3; int g = q % 8; int mat = q / 8;
      const float* W = mat ? p.in[10] : p.in[8];
      u16 o[8];
#pragma unroll
      for (int j = 0; j < 8; ++j) o[j] = f2bf(W[((size_t)g * 96 + ks * 16 + 8 * (lane >> 5) + j) * 96 + jt * 32 + (lane & 31)]);
      uint4 ov; ov.x = o[0] | (o[1] << 16); ov.y = o[2] | (o[3] << 16); ov.z = o[4] | (o[5] << 16); ov.w = o[6] | (o[7] << 16);
      *reinterpret_cast<uint4*>(wf + id * 8) = ov;
    }
  }
}

__device__ __forceinline__ void epi_store_bf16(const f32x16 (&acc)[4][2], u16* __restrict__ Z, int ld, int m0, int n0, u16* Cs) {
  const int tid = tidx_(), lane = tid & 63, w = tid >> 6, wm = w >> 1, wn = w & 1, r = lane & 31, h = lane >> 5;
#pragma unroll
  for (int i = 0; i < 4; ++i)
#pragma unroll
    for (int j = 0; j < 2; ++j)
#pragma unroll
      for (int reg = 0; reg < 16; ++reg)
        Cs[(wm * 128 + i * 32 + crow(reg, h)) * 136 + wn * 64 + j * 32 + r] = f2bf(acc[i][j][reg]);
  __syncthreads();
#pragma unroll 4
  for (int q = tid; q < 256 * 16; q += 256) {
    int row = q >> 4, cc = q & 15;
    *reinterpret_cast<uint4*>(Z + (size_t)(m0 + row) * ld + n0 + cc * 8) = *reinterpret_cast<const uint4*>(Cs + row * 136 + cc * 8);
  }
}
__device__ __forceinline__ void phase_inproj(const Params& p, int layer, unsigned char* smem) {
  unsigned char* ws = p.ws;
  const u16* xb = (const u16*)(ws + OFF_XB);
  u16* Z = (u16*)(ws + OFF_Z);
  const int NT = layer == 0 ? 27 : 14;
  const int nmain = 64 * NT;
  const int nitems = nmain + (layer == 0 ? 32 : 0);
  const int tid = tidx_(), lane = tid & 63, w = tid >> 6, wm = w >> 1, wn = w & 1, r = lane & 31, h = lane >> 5;
  const int rounds_main = (nmain + gridDim.x - 1) / gridDim.x;
  const int nidle = rounds_main * (int)gridDim.x - nmain;
  const int nkv = nitems - nmain;
  const bool kv_in_idle = nidle >= nkv + 64;
  for (int rd = 0; rd < rounds_main + 1; ++rd) {
    f32x16 acc[4][2];
    int nt = 0, mt = 0, it = 0;
    bool main_tile = false;
    if (rd < rounds_main) {
      main_tile = xcd_tile(rd, NT, nmain, mt, nt);
      if (!main_tile) {
        const int j = xcd_idx(rd) - nmain;
        if (kv_in_idle && j < nkv) it = nmain + j;
        else {
          const int j2 = kv_in_idle ? j - nkv : j, n2 = kv_in_idle ? nidle - nkv : nidle;
          const int pc_lo = layer == 0 ? 0 : 3072, pc_hi = layer == 0 ? 3072 : 4096;
          for (int pc = pc_lo + j2; pc < pc_hi; pc += n2) table_piece(p, pc >> 11, pc & 2047);
          continue;
        }
      }
    }
    else { if (kv_in_idle) continue; it = nmain + blockIdx.x; if (it >= nitems) continue; }
    if (main_tile) {
      const u16* Wt = (const u16*)(ws + (layer == 0 ? W_IN0 : W_IN1));
      gemm_mainloop(xb, Wt, mt * 256, nt * 128, (u16*)smem, acc);
      if (layer == 0 && nt == 26) {
        float* gates = (float*)(ws + M_GATES);
        if (wn == 0 && r < 8) {
#pragma unroll
          for (int i = 0; i < 4; ++i)
#pragma unroll
            for (int reg = 0; reg < 16; ++reg) {
              int row = mt * 256 + wm * 128 + i * 32 + crow(reg, h);
              gates[(size_t)row * 8 + r] = acc[i][0][reg];
            }
        }
      } else {
        epi_store_bf16(acc, Z, layer == 0 ? ZLD0 : ZLD1, mt * 256, nt * 128, (u16*)smem);
      }
    } else {
      int q = it - nmain; int lay = q >> 4; mt = (q >> 2) & 3; nt = q & 3;
      const u16* memb = (const u16*)(ws + W_MEM);
      const u16* Wt = (const u16*)(ws + W_KV) + (size_t)lay * 512 * 1024;
      gemm_mainloop(memb, Wt, mt * 256, nt * 128, (u16*)smem, acc);
      u16* Kf = (u16*)(ws + M_KF) + (size_t)lay * 262144;
      u16* Vf = (u16*)(ws + M_VF) + (size_t)lay * 262144;
#pragma unroll
      for (int i = 0; i < 4; ++i)
#pragma unroll
        for (int j = 0; j < 2; ++j)
#pragma unroll
          for (int reg = 0; reg < 16; ++reg) {
            int row = mt * 256 + wm * 128 + i * 32 + crow(reg, h), col = nt * 128 + wn * 64 + j * 32 + r;
            int b = row >> 8, m = row & 255;
            u16 v = f2bf(acc[i][j][reg]);
            if (col < 256) {
              int head = col >> 6, d = col & 63;
              size_t idx = ((((size_t)(b * 4 + head) * 8 + (m >> 5)) * 4 + (d >> 4)) * 512) + ((((d >> 3) & 1) * 32 + (m & 31)) * 8) + (d & 7);
              Kf[idx] = v;
            } else {
              int c2 = col - 256; int head = c2 >> 6, d = c2 & 63;
              size_t idx = ((((size_t)(b * 4 + head) * 2 + (d >> 5)) * 16 + (m >> 4)) * 512) + ((((m >> 3) & 1) * 32 + (d & 31)) * 8) + (m & 7);
              Vf[idx] = v;
            }
          }
    }
  }
  if (rounds_main * (int)gridDim.x == nmain) {
    const int pc_lo = layer == 0 ? 0 : 3072, pc_hi = layer == 0 ? 3072 : 4096;
    for (int pc2 = pc_lo + (int)blockIdx.x; pc2 < pc_hi; pc2 += (int)gridDim.x) table_piece(p, pc2 >> 11, pc2 & 2047);
  }
}
__device__ __forceinline__ void phase_outproj(const Params& p, int layer, unsigned char* smem) {
  unsigned char* ws = p.ws;
  const u16* cat = (const u16*)(ws + OFF_CAT);
  const u16* Wt = (const u16*)(ws + W_OUT) + (size_t)layer * 1024 * 1024;
  const float* res = layer == 0 ? p.in[0] : p.out;
  float* pre = (float*)(ws + OFF_Z);
  const int tid = tidx_(), lane = tid & 63, w = tid >> 6, wm = w >> 1, wn = w & 1, r = lane & 31, h = lane >> 5;
  for (int rd = 0; rd < (512 + (int)gridDim.x - 1) / (int)gridDim.x; ++rd) {
    int nt, mt;
    if (!xcd_tile(rd, 8, 512, mt, nt)) continue;
    f32x16 acc[4][2];
    gemm_mainloop(cat, Wt, mt * 256, nt * 128, (u16*)smem, acc);
    float* Cs = (float*)smem;
#pragma unroll 1
    for (int hf = 0; hf < 2; ++hf) {
      if (wm == hf) {
#pragma unroll
        for (int i = 0; i < 4; ++i)
#pragma unroll
          for (int j = 0; j < 2; ++j)
#pragma unroll
            for (int reg = 0; reg < 16; ++reg) Cs[(i * 32 + crow(reg, h)) * 132 + wn * 64 + j * 32 + r] = acc[i][j][reg];
      }
      __syncthreads();
#pragma unroll 1
      for (int q0 = tid; q0 < 128 * 32; q0 += 256 * 8) {
        f32x4v rv[8];
#pragma unroll
        for (int u = 0; u < 8; ++u) {
          int q = q0 + u * 256; int row = q >> 5, c4 = q & 31;
          rv[u] = *reinterpret_cast<const f32x4v*>(res + (size_t)(mt * 256 + hf * 128 + row) * 1024 + nt * 128 + c4 * 4);
        }
        __builtin_amdgcn_sched_barrier(0);
#pragma unroll
        for (int u = 0; u < 8; ++u) {
          int q = q0 + u * 256; int row = q >> 5, c4 = q & 31;
          f32x4v cv = *reinterpret_cast<const f32x4v*>(Cs + row * 132 + c4 * 4);
          f32x4v ov; ov.x = DN_ALPHA * rv[u].x + cv.x; ov.y = DN_ALPHA * rv[u].y + cv.y; ov.z = DN_ALPHA * rv[u].z + cv.z; ov.w = DN_ALPHA * rv[u].w + cv.w;
          *reinterpret_cast<f32x4v*>(pre + (size_t)(mt * 256 + hf * 128 + row) * 1024 + nt * 128 + c4 * 4) = ov;
        }
      }
      __syncthreads();
    }
  }
}

__device__ __forceinline__ void phase_ln1(const Params& p, int layer) {
  unsigned char* ws = p.ws;
  const float* pre = (const float*)(ws + OFF_Z);
  u16* xb = (u16*)(ws + OFF_XB);
  const float* g = p.in[15] + layer * 1024; const float* bb = p.in[16] + layer * 1024;
  const int lane = tidx_() & 63, w = tidx_() >> 6;
  f32x4v gg[4], b4[4];
#pragma unroll
  for (int i = 0; i < 4; ++i) { gg[i] = *reinterpret_cast<const f32x4v*>(g + i * 256 + lane * 4); b4[i] = *reinterpret_cast<const f32x4v*>(bb + i * 256 + lane * 4); }
  const int rstride = gridDim.x * 4;
  for (int row0 = blockIdx.x * 4 + w; row0 < T_TOK; row0 += 2 * rstride) {
    const int row1 = row0 + rstride;
    const bool has1 = row1 < T_TOK;
    f32x4v v[2][4];
#pragma unroll
    for (int i = 0; i < 4; ++i) {
      v[0][i] = *reinterpret_cast<const f32x4v*>(pre + (size_t)row0 * 1024 + i * 256 + lane * 4);
      v[1][i] = *reinterpret_cast<const f32x4v*>(pre + (size_t)(has1 ? row1 : row0) * 1024 + i * 256 + lane * 4);
    }
    __builtin_amdgcn_sched_barrier(0);
#pragma unroll
    for (int rr = 0; rr < 2; ++rr) {
      if (rr == 1 && !has1) break;
      const int row = rr ? row1 : row0;
      float s = 0.f;
#pragma unroll
      for (int i = 0; i < 4; ++i) s += v[rr][i].x + v[rr][i].y + v[rr][i].z + v[rr][i].w;
      float mu = wsum(s) * (1.f / 1024.f);
      float q = 0.f;
#pragma unroll
      for (int i = 0; i < 4; ++i) { float a = v[rr][i].x - mu, b = v[rr][i].y - mu, c = v[rr][i].z - mu, d = v[rr][i].w - mu; q += a * a + b * b + c * c + d * d; }
      float rstd = rsqrtf(wsum(q) * (1.f / 1024.f) + LN_EPS);
#pragma unroll
      for (int i = 0; i < 4; ++i) {
        int c0 = i * 256 + lane * 4;
        uint2 o; o.x = pack2((v[rr][i].x - mu) * rstd * gg[i].x + b4[i].x, (v[rr][i].y - mu) * rstd * gg[i].y + b4[i].y);
        o.y = pack2((v[rr][i].z - mu) * rstd * gg[i].z + b4[i].z, (v[rr][i].w - mu) * rstd * gg[i].w + b4[i].w);
        *reinterpret_cast<uint2*>(xb + (size_t)row * 1024 + c0) = o;
      }
    }
  }
}

__device__ __forceinline__ void mlstm_A(const Params& p, int item, unsigned char* smem) {
  unsigned char* ws = p.ws;
  const int tid = tidx_(), lane = tid & 63, w = tid >> 6, r = lane & 31, h2 = lane >> 5;
  const int bh = item >> 6, c = item & 63, b = bh >> 2, hd = bh & 3;
  const int t0 = b * SEQ + c * 64;
  const u16* Z = (const u16*)(ws + OFF_Z);
  const float* gates = (const float*)(ws + M_GATES);
  const float* bg = p.in[3];
  u16* Ks = (u16*)smem; u16* Vs = Ks + 64 * 200; float* wgt = (float*)(Vs + 64 * 200);
  __syncthreads();
  if (tid < 64) {
    float ii = gates[(size_t)(t0 + tid) * 8 + hd] + bg[hd];
    float ff = logsigmoidf_(gates[(size_t)(t0 + tid) * 8 + 4 + hd] + bg[4 + hd]);
    float bc = ff;
#pragma unroll
    for (int o = 1; o < 64; o <<= 1) { float t = __shfl_up(bc, o); if (tid >= o) bc += t; }
    float a = ii - bc;
    float M = wmax(a);
    float bl = __shfl(bc, 63);
    wgt[tid] = expf(a - M);
    if (tid == 0) { ((float*)(ws + M_STBL))[bh * 64 + c] = bl; ((float*)(ws + M_STML))[bh * 64 + c] = bl + M; }
  }
  __syncthreads();
  {
    u32x4 kvr[6], vvr[6];
#pragma unroll
    for (int it = 0; it < 6; ++it) {
      int q = tid + it * 256; int l = q / 24, dc = q % 24;
      const u16* zr = Z + (size_t)(t0 + l) * ZLD0 + hd * 192 + dc * 8;
      kvr[it] = *reinterpret_cast<const u32x4*>(zr + 768);
      vvr[it] = *reinterpret_cast<const u32x4*>(zr + 1536);
    }
    __builtin_amdgcn_sched_barrier(0);
#pragma unroll
    for (int it = 0; it < 6; ++it) {
      int q = tid + it * 256; int l = q / 24, dc = q % 24;
      float sc = wgt[l] * 0.07216878364870322f;
      u32x4 kv = kvr[it], ko;
      ko.x = pack2(bflo(kv.x) * sc, bfhi(kv.x) * sc); ko.y = pack2(bflo(kv.y) * sc, bfhi(kv.y) * sc);
      ko.z = pack2(bflo(kv.z) * sc, bfhi(kv.z) * sc); ko.w = pack2(bflo(kv.w) * sc, bfhi(kv.w) * sc);
      *reinterpret_cast<u32x4*>(Ks + l * 200 + dc * 8) = ko;
      *reinterpret_cast<u32x4*>(Vs + l * 200 + dc * 8) = vvr[it];
    }
  }
  __syncthreads();
  u16* KV = (u16*)(ws + OFF_SCR) + (size_t)(bh * 64 + c) * 36864;
  for (int tt = w; tt < 36; tt += 4) {
    int dt = tt / 6, et = tt % 6;
    f32x16 acc = zero16();
#pragma unroll
    for (int ks = 0; ks < 4; ++ks) {
      bf16x8 a = ldsfrag_strided(Ks + (ks * 16 + 8 * h2) * 200 + dt * 32 + r, 200);
      bf16x8 bb = ldsfrag_strided(Vs + (ks * 16 + 8 * h2) * 200 + et * 32 + r, 200);
      acc = __builtin_amdgcn_mfma_f32_32x32x16_bf16(a, bb, acc, 0, 0, 0);
    }
#pragma unroll
    for (int g = 0; g < 4; ++g) {
      size_t idx = ((size_t)(et * 12 + dt * 2 + (g >> 1)) * 64 + (g & 1) * 32 + r) * 8 + 4 * h2;
      uint2 o; o.x = pack2(acc[g * 4 + 0], acc[g * 4 + 1]); o.y = pack2(acc[g * 4 + 2], acc[g * 4 + 3]);
      *reinterpret_cast<uint2*>(KV + idx) = o;
    }
  }
  if (tid < 192) {
    float s = 0.f;
    for (int l = 0; l < 64; ++l) s += bf2f(Ks[l * 200 + tid]);
    ((float*)(ws + M_NLOC))[(size_t)(bh * 64 + c) * 192 + tid] = s;
  }
}

__device__ __forceinline__ void phase_mlstm_scan(const Params& p) {
  unsigned char* ws = p.ws;
  const size_t gtid = (size_t)blockIdx.x * 256 + tidx_(), gsz = (size_t)gridDim.x * 256;
  const float* stbl = (const float*)(ws + M_STBL); const float* stml = (const float*)(ws + M_STML);
  const u16* KV = (const u16*)(ws + OFF_SCR);
  u16* Cin = (u16*)(ws + OFF_SCR + 72 * MiB);
  for (size_t qid = gtid; qid < (size_t)16 * 4608; qid += gsz) {
    int bh = (int)(qid / 4608), qi = (int)(qid % 4608);
    float C[8], m = 0.f;
#pragma unroll
    for (int i = 0; i < 8; ++i) C[i] = 0.f;
    const size_t ob = (size_t)(bh * 64) * 36864 + (size_t)qi * 8;
    u32x4 nx[8];
#pragma unroll
    for (int j = 0; j < 8; ++j) nx[j] = *reinterpret_cast<const u32x4*>(KV + ob + (size_t)j * 36864);
#pragma unroll 1
    for (int c0 = 0; c0 < 64; c0 += 8) {
      u32x4 cur[8];
#pragma unroll
      for (int j = 0; j < 8; ++j) cur[j] = nx[j];
      if (c0 + 8 < 64) {
#pragma unroll
        for (int j = 0; j < 8; ++j) nx[j] = *reinterpret_cast<const u32x4*>(KV + ob + (size_t)(c0 + 8 + j) * 36864);
      }
      __builtin_amdgcn_sched_barrier(0);
#pragma unroll
      for (int j = 0; j < 8; ++j) {
        const int c = c0 + j;
        float bl = stbl[bh * 64 + c], ml = stml[bh * 64 + c];
        float mn = fmaxf(bl + m, ml);
        float dec = expf(bl + m - mn), wl = expf(ml - mn);
        u32x4 kv = cur[j], co;
        co.x = pack2(C[0], C[1]); co.y = pack2(C[2], C[3]); co.z = pack2(C[4], C[5]); co.w = pack2(C[6], C[7]);
        *reinterpret_cast<u32x4*>(Cin + ob + (size_t)c * 36864) = co;
        C[0] = dec * C[0] + wl * bflo(kv.x); C[1] = dec * C[1] + wl * bfhi(kv.x);
        C[2] = dec * C[2] + wl * bflo(kv.y); C[3] = dec * C[3] + wl * bfhi(kv.y);
        C[4] = dec * C[4] + wl * bflo(kv.z); C[5] = dec * C[5] + wl * bfhi(kv.z);
        C[6] = dec * C[6] + wl * bflo(kv.w); C[7] = dec * C[7] + wl * bfhi(kv.w);
        m = mn;
      }
    }
  }
  const float* nloc = (const float*)(ws + M_NLOC); float* nin = (float*)(ws + M_NIN); float* minp = (float*)(ws + M_MIN);
  const size_t rtid = (size_t)(gridDim.x - 1 - blockIdx.x) * 256 + tidx_();
  for (size_t id = rtid; id < (size_t)16 * 192; id += gsz) {
    int bh = (int)(id / 192), d = (int)(id % 192);
    float n = 0.f, m = 0.f;
#pragma unroll 1
    for (int c0 = 0; c0 < 64; c0 += 16) {
      float nl[16];
#pragma unroll
      for (int j = 0; j < 16; ++j) nl[j] = nloc[(size_t)(bh * 64 + c0 + j) * 192 + d];
      __builtin_amdgcn_sched_barrier(0);
#pragma unroll
      for (int j = 0; j < 16; ++j) {
        const int c = c0 + j;
        float bl = stbl[bh * 64 + c], ml = stml[bh * 64 + c];
        float mn = fmaxf(bl + m, ml);
        float dec = expf(bl + m - mn), wl = expf(ml - mn);
        size_t o = (size_t)(bh * 64 + c) * 192 + d;
        nin[o] = n;
        if (d == 0) minp[bh * 64 + c] = m;
        n = dec * n + wl * nl[j];
        m = mn;
      }
    }
  }
}

__device__ __forceinline__ void mlstm_C(const Params& p, int item, unsigned char* smem) {
  unsigned char* ws = p.ws;
  const int tid = tidx_(), lane = tid & 63, w = tid >> 6, r = lane & 31, h2 = lane >> 5;
  const int bh = item >> 7, c = (item >> 1) & 63, half = item & 1, b = bh >> 2, hd = bh & 3;
  const int t0 = b * SEQ + c * 64, l0 = half * 32;
  const u16* Z = (const u16*)(ws + OFF_Z);
  const float* gates = (const float*)(ws + M_GATES);
  const float* bg = p.in[3];
  u16* Qs = (u16*)smem;
  u16* Ks = Qs + 32 * 200;
  u16* Vs = Ks + 64 * 200;
  float* Ss = (float*)(Vs + 64 * 200);
  u16* Ps = (u16*)(Ss + 32 * 72);
  float* sA = (float*)(Ps + 32 * 72);
  float* sG = sA + 64;
  float* sSc = sG + 64;
  float* sEm = sSc + 64;
  float* sQn = sEm + 64;
  float* sInv = sQn + 32;
  float* sN = sInv + 32;
  float* Hs = (float*)Ks;
  __syncthreads();
  if (tid < 64) {
    float ii = gates[(size_t)(t0 + tid) * 8 + hd] + bg[hd];
    float ff = logsigmoidf_(gates[(size_t)(t0 + tid) * 8 + 4 + hd] + bg[4 + hd]);
    float bc = ff;
#pragma unroll
    for (int o = 1; o < 64; o <<= 1) { float t = __shfl_up(bc, o); if (tid >= o) bc += t; }
    float a = ii - bc;
    float M = a;
#pragma unroll
    for (int o = 1; o < 64; o <<= 1) { float t = __shfl_up(M, o); if (tid >= o) M = fmaxf(M, t); }
    float m_in = ((const float*)(ws + M_MIN))[bh * 64 + c];
    float g = fmaxf(M, m_in);
    sA[tid] = a; sG[tid] = g; sSc[tid] = expf(m_in - g); sEm[tid] = expf(-(bc + g));
  }
  {
    u32x4 kvr[6], vvr[6], qvr[3];
#pragma unroll
    for (int it = 0; it < 6; ++it) {
      int q = tid + it * 256; int l = q / 24, dc = q % 24;
      const u16* zr = Z + (size_t)(t0 + l) * ZLD0 + hd * 192 + dc * 8;
      kvr[it] = *reinterpret_cast<const u32x4*>(zr + 768);
      vvr[it] = *reinterpret_cast<const u32x4*>(zr + 1536);
      if (it < 3) qvr[it] = *reinterpret_cast<const u32x4*>(Z + (size_t)(t0 + l0 + l) * ZLD0 + hd * 192 + dc * 8);
    }
    if (tid < 192) sN[tid] = ((const float*)(ws + M_NIN))[(size_t)(bh * 64 + c) * 192 + tid];
    __builtin_amdgcn_sched_barrier(0);
#pragma unroll
    for (int it = 0; it < 6; ++it) {
      int q = tid + it * 256; int l = q / 24, dc = q % 24;
      const float sc = 0.07216878364870322f;
      u32x4 kv = kvr[it], ko;
      ko.x = pack2(bflo(kv.x) * sc, bfhi(kv.x) * sc); ko.y = pack2(bflo(kv.y) * sc, bfhi(kv.y) * sc);
      ko.z = pack2(bflo(kv.z) * sc, bfhi(kv.z) * sc); ko.w = pack2(bflo(kv.w) * sc, bfhi(kv.w) * sc);
      *reinterpret_cast<u32x4*>(Ks + l * 200 + dc * 8) = ko;
      *reinterpret_cast<u32x4*>(Vs + l * 200 + dc * 8) = vvr[it];
      if (it < 3) *reinterpret_cast<u32x4*>(Qs + l * 200 + dc * 8) = qvr[it];
    }
  }
  __syncthreads();
  if (w < 2) {
    f32x16 acc = zero16();
#pragma unroll
    for (int ks = 0; ks < 12; ++ks) {
      bf16x8 a = ldsfrag(Qs + r * 200 + ks * 16 + h2 * 8);
      bf16x8 bb = ldsfrag(Ks + (w * 32 + r) * 200 + ks * 16 + h2 * 8);
      acc = __builtin_amdgcn_mfma_f32_32x32x16_bf16(a, bb, acc, 0, 0, 0);
    }
#pragma unroll
    for (int reg = 0; reg < 16; ++reg) Ss[crow(reg, h2) * 72 + w * 32 + r] = acc[reg];
  } else {
    int t2 = tid - 128; int l = t2 >> 2, part = t2 & 3;
    float s = 0.f;
    for (int d = part * 48; d < part * 48 + 48; ++d) s += bf2f(Qs[l * 200 + d]) * sN[d];
    s += __shfl_xor(s, 1); s += __shfl_xor(s, 2);
    if (part == 0) sQn[l] = s;
  }
  __syncthreads();
  {
    int l = tid >> 3, sub = tid & 7; int L = l0 + l;
    float gL = sG[L]; float rs = 0.f;
#pragma unroll
    for (int i = 0; i < 8; ++i) {
      int s = sub + 8 * i;
      float pv = 0.f;
      if (s <= L) pv = Ss[l * 72 + s] * expf(sA[s] - gL);
      rs += pv;
      Ps[l * 72 + s] = f2bf(pv);
    }
    rs += __shfl_xor(rs, 1); rs += __shfl_xor(rs, 2); rs += __shfl_xor(rs, 4);
    if (sub == 0) {
      float den = sSc[L] * sQn[l] + rs;
      sInv[l] = 1.f / fmaxf(fabsf(den), sEm[L]);
    }
  }
  __syncthreads();
  const u16* Cin = (const u16*)(ws + OFF_SCR + 72 * MiB) + (size_t)(bh * 64 + c) * 36864;
  for (int et = w; et < 6; et += 4) {
    f32x16 acc = zero16();
    const u16* cf = Cin + (size_t)(et * 12) * 512 + lane * 8;
    bf16x8 cfr[12];
#pragma unroll
    for (int ks = 0; ks < 12; ++ks) cfr[ks] = gfrag(cf + ks * 512);
    __builtin_amdgcn_sched_barrier(0);
#pragma unroll
    for (int ks = 0; ks < 12; ++ks) {
      bf16x8 a = ldsfrag(Qs + r * 200 + ks * 16 + h2 * 8);
      acc = __builtin_amdgcn_mfma_f32_32x32x16_bf16(a, cfr[ks], acc, 0, 0, 0);
    }
#pragma unroll
    for (int reg = 0; reg < 16; ++reg) acc[reg] *= sSc[l0 + crow(reg, h2)];
#pragma unroll
    for (int ks = 0; ks < 4; ++ks) {
      bf16x8 a = ldsfrag(Ps + r * 72 + ks * 16 + h2 * 8);
      bf16x8 bb = ldsfrag_strided(Vs + (ks * 16 + 8 * h2) * 200 + et * 32 + r, 200);
      acc = __builtin_amdgcn_mfma_f32_32x32x16_bf16(a, bb, acc, 0, 0, 0);
    }
#pragma unroll
    for (int reg = 0; reg < 16; ++reg) { int row = crow(reg, h2); Hs[row * 196 + et * 32 + r] = acc[reg] * sInv[row]; }
  }
  __syncthreads();
  {
    int l = tid >> 3, sub = tid & 7;
    float s = 0.f;
    for (int i = 0; i < 24; ++i) s += Hs[l * 196 + sub + 8 * i];
    s += __shfl_xor(s, 1); s += __shfl_xor(s, 2); s += __shfl_xor(s, 4);
    float mu = s * (1.f / 192.f);
    float q = 0.f;
    for (int i = 0; i < 24; ++i) { float d = Hs[l * 196 + sub + 8 * i] - mu; q += d * d; }
    q += __shfl_xor(q, 1); q += __shfl_xor(q, 2); q += __shfl_xor(q, 4);
    float rstd = rsqrtf(q * (1.f / 192.f) + LN_EPS);
    const float* ng = p.in[4] + hd * 192;
    size_t tok = (size_t)(t0 + l0 + l);
    const u16* orow = Z + tok * ZLD0 + 2304 + hd * 192;
    u16* cat = (u16*)(ws + OFF_CAT) + tok * 1024 + hd * 192;
    float ngv[24], ov[24];
#pragma unroll
    for (int i = 0; i < 24; ++i) { ngv[i] = ng[sub + 8 * i]; ov[i] = bf2f(orow[sub + 8 * i]); }
    __builtin_amdgcn_sched_barrier(0);
#pragma unroll
    for (int i = 0; i < 24; ++i) {
      int e = sub + 8 * i;
      float hn = (Hs[l * 196 + e] - mu) * rstd * ngv[i];
      cat[e] = f2bf(hn * sigmoidf_(ov[i]));
    }
  }
}

__device__ __forceinline__ void xattn_item(const Params& p, int layer, int item, unsigned char* smem) {
  unsigned char* ws = p.ws;
  const int tid = tidx_(), lane = tid & 63, w = tid >> 6, r = lane & 31, h2 = lane >> 5;
  const int head = item & 3, tt = item >> 2;
  const int tok0 = tt * 32, b = tok0 / SEQ;
  const u16* Z = (const u16*)(ws + OFF_Z);
  const int zld = layer == 0 ? ZLD0 : ZLD1, xq = layer == 0 ? 3072 : 1536;
  const u16* Kf = (const u16*)(ws + M_KF) + (size_t)layer * 262144 + (size_t)(b * 4 + head) * 8 * 4 * 512;
  const u16* Vf = (const u16*)(ws + M_VF) + (size_t)layer * 262144 + (size_t)(b * 4 + head) * 2 * 16 * 512;
  u16* Qs = (u16*)smem;
  float* Ss = (float*)(Qs + 32 * 72);
  u16* Ps = (u16*)(Ss + 32 * 264);
  float* rinv = (float*)(Ps + 32 * 264);
  __syncthreads();
  bf16x8 kf[8];
#pragma unroll
  for (int i = 0; i < 8; ++i) kf[i] = gfrag(Kf + (size_t)(w * 8 + i) * 512 + lane * 8);
  {
    int l = tid >> 3, cc = tid & 7;
    u32x4 qv = *reinterpret_cast<const u32x4*>(Z + (size_t)(tok0 + l) * zld + xq + head * 64 + cc * 8);
    __builtin_amdgcn_sched_barrier(0);
    *reinterpret_cast<u32x4*>(Qs + l * 72 + cc * 8) = qv;
  }
  __syncthreads();
#pragma unroll
  for (int mm = 0; mm < 2; ++mm) {
    int mt = w * 2 + mm;
    f32x16 acc = zero16();
#pragma unroll
    for (int ks = 0; ks < 4; ++ks) {
      bf16x8 a = ldsfrag(Qs + r * 72 + ks * 16 + h2 * 8);
      acc = __builtin_amdgcn_mfma_f32_32x32x16_bf16(a, kf[mm * 4 + ks], acc, 0, 0, 0);
    }
#pragma unroll
    for (int reg = 0; reg < 16; ++reg) Ss[crow(reg, h2) * 264 + mt * 32 + r] = acc[reg] * 0.125f;
  }
  bf16x8 vf[16];
  if (w < 2) {
#pragma unroll
    for (int ks = 0; ks < 16; ++ks) vf[ks] = gfrag(Vf + (size_t)(w * 16 + ks) * 512 + lane * 8);
  }
  __builtin_amdgcn_sched_barrier(0);
  __syncthreads();
  {
    int l = tid >> 3, sub = tid & 7;
    float mx = -3.0e38f;
    float sv[32];
#pragma unroll
    for (int i = 0; i < 32; ++i) { sv[i] = Ss[l * 264 + sub + 8 * i]; mx = fmaxf(mx, sv[i]); }
    mx = fmaxf(mx, __shfl_xor(mx, 1)); mx = fmaxf(mx, __shfl_xor(mx, 2)); mx = fmaxf(mx, __shfl_xor(mx, 4));
    float s = 0.f;
#pragma unroll
    for (int i = 0; i < 32; ++i) { float e = __expf(sv[i] - mx); Ps[l * 264 + sub + 8 * i] = f2bf(e); s += e; }
    s += __shfl_xor(s, 1); s += __shfl_xor(s, 2); s += __shfl_xor(s, 4);
    if (sub == 0) rinv[l] = 1.f / s;
  }
  __syncthreads();
  if (w < 2) {
    f32x16 acc = zero16();
#pragma unroll
    for (int ks = 0; ks < 16; ++ks) {
      bf16x8 a = ldsfrag(Ps + r * 264 + ks * 16 + h2 * 8);
      acc = __builtin_amdgcn_mfma_f32_32x32x16_bf16(a, vf[ks], acc, 0, 0, 0);
    }
    u16* cat = (u16*)(ws + OFF_CAT);
#pragma unroll
    for (int reg = 0; reg < 16; ++reg) cat[(size_t)(tok0 + crow(reg, h2)) * 1024 + 768 + head * 64 + w * 32 + r] = f2bf(acc[reg] * rinv[crow(reg, h2)]);
  }
}

__device__ __forceinline__ void rglru_1(const Params& p, int item, unsigned char* smem) {
  unsigned char* ws = p.ws;
  const int tid = tidx_(), lane = tid & 63, w = tid >> 6, r = lane & 31, h2 = lane >> 5;
  const int b = item >> 7, c = item & 127;
  const int t0 = b * SEQ + c * 32;
  const u16* Z = (const u16*)(ws + OFF_Z);
  const float* cw = p.in[6]; const float* cb = p.in[7];
  u16* xc = (u16*)smem;
  float* PA = (float*)(ws + OFF_SCR); float* HU = (float*)(ws + OFF_SCR + 48 * MiB);
  __syncthreads();
#pragma unroll 1
  for (int q = tid; q < 32 * 96; q += 256) {
    int l = q / 96, cc = q % 96, ch0 = cc * 8;
    u32x4 xv[4]; f32x4v wlo[4], whi[4];
#pragma unroll
    for (int j = 0; j < 4; ++j) {
      int pp = c * 32 + l - 3 + j; int ppc = pp < 0 ? 0 : pp;
      xv[j] = *reinterpret_cast<const u32x4*>(Z + (size_t)(b * SEQ + ppc) * ZLD1 + 768 + ch0);
      wlo[j] = *reinterpret_cast<const f32x4v*>(cw + j * 768 + ch0); whi[j] = *reinterpret_cast<const f32x4v*>(cw + j * 768 + ch0 + 4);
    }
    float4 c0 = *reinterpret_cast<const float4*>(cb + ch0), c1 = *reinterpret_cast<const float4*>(cb + ch0 + 4);
    __builtin_amdgcn_sched_barrier(0);
    float a[8] = {c0.x, c0.y, c0.z, c0.w, c1.x, c1.y, c1.z, c1.w};
#pragma unroll
    for (int j = 0; j < 4; ++j) {
      const float vm = (c * 32 + l - 3 + j) >= 0 ? 1.f : 0.f;
      a[0] += vm * wlo[j].x * bflo(xv[j].x); a[1] += vm * wlo[j].y * bfhi(xv[j].x); a[2] += vm * wlo[j].z * bflo(xv[j].y); a[3] += vm * wlo[j].w * bfhi(xv[j].y);
      a[4] += vm * whi[j].x * bflo(xv[j].z); a[5] += vm * whi[j].y * bfhi(xv[j].z); a[6] += vm * whi[j].z * bflo(xv[j].w); a[7] += vm * whi[j].w * bfhi(xv[j].w);
    }
    uint4 o; o.x = pack2(a[0], a[1]); o.y = pack2(a[2], a[3]); o.z = pack2(a[4], a[5]); o.w = pack2(a[6], a[7]);
    *reinterpret_cast<uint4*>(xc + l * 776 + ch0) = o;
  }
  __syncthreads();
  const u16* Waf = (const u16*)(ws + W_AF); const u16* Wxf = Waf + 8 * 3 * 6 * 512;
  const float* ba = p.in[9]; const float* bx = p.in[11]; const float* lam = p.in[12];
  float* As_ = (float*)(smem + 49664);
  float* Us_ = As_ + 32 * 97;
  float* sumP = (float*)(ws + M_SUMP); float* sumH = (float*)(ws + M_SUMH);
  bf16x8 b1[6], b2[6];
  if (w < 3) {
#pragma unroll
    for (int ks = 0; ks < 6; ++ks) {
      b1[ks] = gfrag(Waf + (size_t)((0 * 3 + w) * 6 + ks) * 512 + lane * 8);
      b2[ks] = gfrag(Wxf + (size_t)((0 * 3 + w) * 6 + ks) * 512 + lane * 8);
    }
  }
#pragma unroll 1
  for (int g = 0; g < 8; ++g) {
    if (w < 3) {
      const int jt = w;
      f32x16 aa = zero16(), ax = zero16();
#pragma unroll
      for (int ks = 0; ks < 6; ++ks) {
        bf16x8 a = ldsfrag(xc + r * 776 + g * 96 + ks * 16 + h2 * 8);
        aa = __builtin_amdgcn_mfma_f32_32x32x16_bf16(a, b1[ks], aa, 0, 0, 0);
        ax = __builtin_amdgcn_mfma_f32_32x32x16_bf16(a, b2[ks], ax, 0, 0, 0);
      }
      __builtin_amdgcn_sched_barrier(0);
      if (g + 1 < 8) {
#pragma unroll
        for (int ks = 0; ks < 6; ++ks) {
          b1[ks] = gfrag(Waf + (size_t)(((g + 1) * 3 + jt) * 6 + ks) * 512 + lane * 8);
          b2[ks] = gfrag(Wxf + (size_t)(((g + 1) * 3 + jt) * 6 + ks) * 512 + lane * 8);
        }
      }
      __builtin_amdgcn_sched_barrier(0);
      const int chl = jt * 32 + r, ch = g * 96 + chl;
      const float bav = ba[ch], bxv = bx[ch], spl = softplusf_(-lam[ch]);
#pragma unroll
      for (int reg = 0; reg < 16; ++reg) {
        int l = crow(reg, h2);
        float rr = __builtin_amdgcn_rcpf(1.f + __expf(-(aa[reg] + bav))), ig = __builtin_amdgcn_rcpf(1.f + __expf(-(ax[reg] + bxv)));
        float la = -8.f * rr * spl;
        float av = __expf(la);
        float x2 = 2.f * la;
        float om_t = -x2 * (1.f + x2 * 0.5f * (1.f + x2 * (1.f / 3.f) * (1.f + x2 * 0.25f * (1.f + x2 * 0.2f))));
        float om = (x2 > -0.1f) ? om_t : (1.f - av * av);
        As_[l * 97 + chl] = av;
        Us_[l * 97 + chl] = __builtin_amdgcn_sqrtf(om) * ig * bf2f(xc[l * 776 + ch]);
      }
    }
    __syncthreads();
    if (tid < 96) {
      const int ch = g * 96 + tid;
      float P = 1.f, H = 0.f;
#pragma unroll 8
      for (int l = 0; l < 32; ++l) {
        float a = As_[l * 97 + tid], u = Us_[l * 97 + tid];
        H = a * H + u; P *= a;
        size_t o = (size_t)(t0 + l) * 768 + ch;
        PA[o] = P; HU[o] = H;
      }
      sumP[(size_t)(b * 128 + c) * 768 + ch] = P; sumH[(size_t)(b * 128 + c) * 768 + ch] = H;
    }
    __syncthreads();
  }
}
__device__ __forceinline__ void rglru_2(const Params& p, int item) {
  unsigned char* ws = p.ws;
  const int tid = tidx_();
  const int b = item >> 7, c = item & 127;
  const int t0 = b * SEQ + c * 32;
  const u16* Z = (const u16*)(ws + OFF_Z);
  const float* PA = (const float*)(ws + OFF_SCR); const float* HU = (const float*)(ws + OFF_SCR + 48 * MiB);
  const float* sumP = (const float*)(ws + M_SUMP); const float* sumH = (const float*)(ws + M_SUMH);
  u16* cat = (u16*)(ws + OFF_CAT);
  float H[3] = {0.f, 0.f, 0.f};
  for (int c0 = 0; c0 < c; c0 += 8) {
    float sp[3][8], sh[3][8];
#pragma unroll
    for (int k = 0; k < 3; ++k)
#pragma unroll
      for (int j = 0; j < 8; ++j) {
        const int c2 = (c0 + j < c) ? c0 + j : c0;
        const size_t o = (size_t)(b * 128 + c2) * 768 + tid + k * 256;
        sp[k][j] = sumP[o]; sh[k][j] = sumH[o];
      }
    __builtin_amdgcn_sched_barrier(0);
#pragma unroll
    for (int j = 0; j < 8; ++j)
      if (c0 + j < c) {
#pragma unroll
        for (int k = 0; k < 3; ++k) H[k] = sp[k][j] * H[k] + sh[k][j];
      }
  }
#pragma unroll 1
  for (int l0 = 0; l0 < 32; l0 += 8) {
    float hu[3][8], pa[3][8], gt[3][8];
#pragma unroll
    for (int k = 0; k < 3; ++k)
#pragma unroll
      for (int j = 0; j < 8; ++j) {
        const size_t t = (size_t)(t0 + l0 + j); const int ch = tid + k * 256;
        hu[k][j] = HU[t * 768 + ch]; pa[k][j] = PA[t * 768 + ch]; gt[k][j] = bf2f(Z[t * ZLD1 + ch]);
      }
    __builtin_amdgcn_sched_barrier(0);
#pragma unroll
    for (int k = 0; k < 3; ++k)
#pragma unroll
      for (int j = 0; j < 8; ++j) {
        const size_t t = (size_t)(t0 + l0 + j); const int ch = tid + k * 256;
        cat[t * 1024 + ch] = f2bf((hu[k][j] + pa[k][j] * H[k]) * geluf_(gt[k][j]));
      }
  }
}

__device__ __forceinline__ void peer_q_item(const Params& p, int layer, int item, unsigned char* smem) {
  unsigned char* ws = p.ws;
  const int tid = tidx_(), lane = tid & 63, w = tid >> 6, wm = w >> 1, wn = w & 1, r = lane & 31, h2 = lane >> 5;
  const int hd = item & 7, mt = item >> 3;
  const u16* xb = (const u16*)(ws + OFF_XB);
  const u16* Wt = (const u16*)(ws + W_Q) + (size_t)layer * 2048 * 1024;
  const u16* skf = (const u16*)(ws + W_SK) + (size_t)layer * 2 * 16384;
  float* TK = (float*)(ws + OFF_TK);
  u16* Qs = (u16*)smem;
  float* Sf = (float*)smem;
  float* tmp = (float*)(smem + 69632);
#pragma unroll 1
  for (int pp = 0; pp < 2; ++pp) {
    f32x16 acc[4][2];
    gemm_mainloop(xb, Wt, mt * 256, (hd * 2 + pp) * 128, (u16*)smem, acc);
#pragma unroll
    for (int i = 0; i < 4; ++i)
#pragma unroll
      for (int j = 0; j < 2; ++j)
#pragma unroll
        for (int reg = 0; reg < 16; ++reg) Qs[(wm * 128 + i * 32 + crow(reg, h2)) * 136 + wn * 64 + j * 32 + r] = f2bf(acc[i][j][reg]);
    __syncthreads();
#pragma unroll
    for (int i = 0; i < 4; ++i)
#pragma unroll
      for (int j = 0; j < 2; ++j) acc[i][j] = zero16();
    const u16* skp = skf + (size_t)pp * 16384 + (size_t)(wn * 2) * 8 * 512 + lane * 8;
#pragma unroll
    for (int kg = 0; kg < 2; ++kg) {
      bf16x8 b0[4], b1[4];
#pragma unroll
      for (int k4 = 0; k4 < 4; ++k4) { b0[k4] = gfrag(skp + (kg * 4 + k4) * 512); b1[k4] = gfrag(skp + (8 + kg * 4 + k4) * 512); }
      __builtin_amdgcn_sched_barrier(0);
#pragma unroll
      for (int k4 = 0; k4 < 4; ++k4) {
        const int kk = kg * 4 + k4;
#pragma unroll
        for (int i = 0; i < 4; ++i) {
          bf16x8 a = ldsfrag(Qs + (wm * 128 + i * 32 + r) * 136 + kk * 16 + h2 * 8);
          acc[i][0] = __builtin_amdgcn_mfma_f32_32x32x16_bf16(a, b0[k4], acc[i][0], 0, 0, 0);
          acc[i][1] = __builtin_amdgcn_mfma_f32_32x32x16_bf16(a, b1[k4], acc[i][1], 0, 0, 0);
        }
      }
    }
    __syncthreads();
#pragma unroll 1
    for (int hf = 0; hf < 2; ++hf) {
      if (wm == hf) {
#pragma unroll
        for (int i = 0; i < 4; ++i)
#pragma unroll
          for (int j = 0; j < 2; ++j)
#pragma unroll
            for (int reg = 0; reg < 16; ++reg) Sf[(i * 32 + crow(reg, h2)) * 129 + wn * 64 + j * 32 + r] = acc[i][j][reg];
      }
      __syncthreads();
      {
        int row = tid & 127, half = tid >> 7;
        float s[16];
#pragma unroll
        for (int i = 0; i < 16; ++i) s[i] = -3.0e38f;
#pragma unroll 4
        for (int j = 0; j < 64; ++j) {
          int key = half * 64 + j;
          float v = Sf[row * 129 + key];
          v = __uint_as_float((__float_as_uint(v) & ~127u) | (unsigned)key);
          ins16(s, v);
        }
        if (half == 1) {
#pragma unroll
          for (int i = 0; i < 16; ++i) tmp[row * 17 + i] = s[i];
        }
        __syncthreads();
        if (half == 0) {
#pragma unroll
          for (int i = 0; i < 16; ++i) ins16(s, tmp[row * 17 + i]);
          float* dst = TK + ((size_t)(mt * 256 + hf * 128 + row) * 8 + hd) * 32 + pp * 16;
#pragma unroll
          for (int i = 0; i < 4; ++i) *reinterpret_cast<float4*>(dst + i * 4) = make_float4(s[i * 4], s[i * 4 + 1], s[i * 4 + 2], s[i * 4 + 3]);
        }
      }
    }
  }
  __syncthreads();
  {
    const size_t tok = (size_t)mt * 256 + tid;
    const float* tk = TK + (tok * 8 + hd) * 32;
    float f0[16], f1[16], s[16];
#pragma unroll
    for (int i = 0; i < 4; ++i) {
      float4 a = *reinterpret_cast<const float4*>(tk + i * 4), b = *reinterpret_cast<const float4*>(tk + 16 + i * 4);
      f0[i * 4] = a.x; f0[i * 4 + 1] = a.y; f0[i * 4 + 2] = a.z; f0[i * 4 + 3] = a.w;
      f1[i * 4] = b.x; f1[i * 4 + 1] = b.y; f1[i * 4 + 2] = b.z; f1[i * 4 + 3] = b.w;
    }
#pragma unroll
    for (int i = 0; i < 16; ++i) s[i] = -3.0e38f;
#pragma unroll
    for (int i = 0; i < 16; ++i)
#pragma unroll
      for (int j = 0; j < 16; ++j)
        if ((i + 1) * (j + 1) <= 16) {
          float v = f0[i] + f1[j];
          v = __uint_as_float((__float_as_uint(v) & ~255u) | (unsigned)(i * 16 + j));
          ins16(s, v);
        }
    float e[16], sum = 0.f;
#pragma unroll
    for (int k = 0; k < 16; ++k) { e[k] = __expf(s[k] - s[0]); sum += e[k]; }
    float inv = 1.f / sum;
    int* se = (int*)(ws + OFF_SEL) + tok * 128 + hd * 16;
    float* sg = (float*)(ws + OFF_SEL + 8 * MiB) + tok * 128 + hd * 16;
    const unsigned* tku = reinterpret_cast<const unsigned*>(tk);
    unsigned i0v[16], i1v[16];
#pragma unroll
    for (int k = 0; k < 16; ++k) {
      unsigned code = __float_as_uint(s[k]) & 255u;
      i0v[k] = tku[code >> 4]; i1v[k] = tku[16 + (code & 15u)];
    }
    __builtin_amdgcn_sched_barrier(0);
#pragma unroll
    for (int k4 = 0; k4 < 4; ++k4) {
      int4 ev; float4 gv;
      ev.x = (int)((i0v[k4 * 4] & 127u) * 128u + (i1v[k4 * 4] & 127u)); ev.y = (int)((i0v[k4 * 4 + 1] & 127u) * 128u + (i1v[k4 * 4 + 1] & 127u));
      ev.z = (int)((i0v[k4 * 4 + 2] & 127u) * 128u + (i1v[k4 * 4 + 2] & 127u)); ev.w = (int)((i0v[k4 * 4 + 3] & 127u) * 128u + (i1v[k4 * 4 + 3] & 127u));
      gv.x = e[k4 * 4] * inv; gv.y = e[k4 * 4 + 1] * inv; gv.z = e[k4 * 4 + 2] * inv; gv.w = e[k4 * 4 + 3] * inv;
      *reinterpret_cast<int4*>(se + k4 * 4) = ev;
      *reinterpret_cast<float4*>(sg + k4 * 4) = gv;
    }
  }
}

typedef float f2v_ __attribute__((ext_vector_type(2)));
#define FP8_DOT4P(W, XA, XB, ACC2) do { f2v_ lo_ = __builtin_amdgcn_cvt_pk_f32_fp8((int)(W), false); f2v_ hi_ = __builtin_amdgcn_cvt_pk_f32_fp8((int)(W), true); \
    ACC2 = __builtin_elementwise_fma(lo_, XA, ACC2); ACC2 = __builtin_elementwise_fma(hi_, XB, ACC2); } while (0)
#define FP8_AXPY4P(W, CF2, YA, YB) do { f2v_ lo_ = __builtin_amdgcn_cvt_pk_f32_fp8((int)(W), false); f2v_ hi_ = __builtin_amdgcn_cvt_pk_f32_fp8((int)(W), true); \
    YA = __builtin_elementwise_fma(lo_, CF2, YA); YB = __builtin_elementwise_fma(hi_, CF2, YB); } while (0)
__device__ __forceinline__ void phase_peer_experts(const Params& p, int layer) {
  unsigned char* ws = p.ws;
  const int lane = tidx_() & 63, w = tidx_() >> 6;
  const float* pre = (const float*)(ws + OFF_Z);
  const unsigned char* ub = ws + OFF_TAB + (size_t)(layer * 2) * 16384 * 1024;
  const unsigned char* vb = ub + (size_t)16384 * 1024;
  const float* usc = (const float*)(ws + M_TSC) + (size_t)(layer * 2) * 16384;
  const float* vsc = usc + 16384;
  const int* se = (const int*)(ws + OFF_SEL); const float* sg = (const float*)(ws + OFF_SEL + 8 * MiB);
  const float* g1 = p.in[15] + layer * 1024; const float* b1 = p.in[16] + layer * 1024;
  const float* g2 = p.in[21] + layer * 1024; const float* b2 = p.in[22] + layer * 1024;
  u16* xb = (u16*)(ws + OFF_XB);
  float* xo = p.out;
  const int e0 = lane * 16;
  for (int tok = blockIdx.x * 4 + w; tok < T_TOK; tok += gridDim.x * 4) {
    float x[16];
    {
      const float* pr = pre + (size_t)tok * 1024 + e0;
      float4 a = *reinterpret_cast<const float4*>(pr), b = *reinterpret_cast<const float4*>(pr + 4);
      float4 c = *reinterpret_cast<const float4*>(pr + 8), d = *reinterpret_cast<const float4*>(pr + 12);
      x[0] = a.x; x[1] = a.y; x[2] = a.z; x[3] = a.w; x[4] = b.x; x[5] = b.y; x[6] = b.z; x[7] = b.w;
      x[8] = c.x; x[9] = c.y; x[10] = c.z; x[11] = c.w; x[12] = d.x; x[13] = d.y; x[14] = d.z; x[15] = d.w;
      float s = 0.f;
#pragma unroll
      for (int i = 0; i < 16; ++i) s += x[i];
      float mu = wsum(s) * (1.f / 1024.f);
      float q = 0.f;
#pragma unroll
      for (int i = 0; i < 16; ++i) { float t = x[i] - mu; q += t * t; }
      float rstd = rsqrtf(wsum(q) * (1.f / 1024.f) + LN_EPS);
#pragma unroll
      for (int i = 0; i < 16; ++i) x[i] = (x[i] - mu) * rstd * g1[e0 + i] + b1[e0 + i];
    }
    int eA = se[(size_t)tok * 128 + lane], eB = se[(size_t)tok * 128 + 64 + lane];
    float gA = sg[(size_t)tok * 128 + lane], gB = sg[(size_t)tok * 128 + 64 + lane];
    float uA = usc[eA], uB = usc[eB];
    gA *= vsc[eA]; gB *= vsc[eB];
    f2v_ x2[8], y2[8];
#pragma unroll
    for (int i = 0; i < 8; ++i) { x2[i].x = x[2 * i]; x2[i].y = x[2 * i + 1]; y2[i].x = 0.f; y2[i].y = 0.f; }
#pragma unroll 1
    for (int hsel = 0; hsel < 2; ++hsel) {
    const int eS = hsel ? eB : eA; const float gS = hsel ? gB : gA, uS = hsel ? uB : uA;
#pragma unroll 1
    for (int bt = 0; bt < 8; ++bt) {
      uint4 U[8], V[8];
#pragma unroll
      for (int k = 0; k < 8; ++k) {
        int idx = bt * 8 + k;
        int eid = __builtin_amdgcn_readlane(eS, idx);
        U[k] = *reinterpret_cast<const uint4*>(ub + (size_t)eid * 1024 + e0);
        V[k] = *reinterpret_cast<const uint4*>(vb + (size_t)eid * 1024 + e0);
      }
      float w1;
      {
        const bool b0 = (lane & 1) != 0, b1 = (lane & 2) != 0, b2 = (lane & 4) != 0;
        float d8[8];
#pragma unroll
        for (int k = 0; k < 8; ++k) {
          f2v_ d2; d2.x = 0.f; d2.y = 0.f;
          FP8_DOT4P(U[k].x, x2[0], x2[1], d2);
          FP8_DOT4P(U[k].y, x2[2], x2[3], d2);
          FP8_DOT4P(U[k].z, x2[4], x2[5], d2);
          FP8_DOT4P(U[k].w, x2[6], x2[7], d2);
          d8[k] = d2.x + d2.y;
        }
        float w4[4], w2[2];
#pragma unroll
        for (int m = 0; m < 4; ++m) { float keep = b0 ? d8[2 * m + 1] : d8[2 * m], send = b0 ? d8[2 * m] : d8[2 * m + 1]; w4[m] = keep + __shfl_xor(send, 1); }
#pragma unroll
        for (int m = 0; m < 2; ++m) { float keep = b1 ? w4[2 * m + 1] : w4[2 * m], send = b1 ? w4[2 * m] : w4[2 * m + 1]; w2[m] = keep + __shfl_xor(send, 2); }
        { float keep = b2 ? w2[1] : w2[0], send = b2 ? w2[0] : w2[1]; w1 = keep + __shfl_xor(send, 4); }
        w1 += __shfl_xor(w1, 8);
        w1 += __shfl_xor(w1, 16);
        w1 += __shfl_xor(w1, 32);
      }
      const float cfl = gS * geluf_(w1 * uS);
#pragma unroll
      for (int k = 0; k < 8; ++k) {
        float cf = __int_as_float(__builtin_amdgcn_readlane(__float_as_int(cfl), bt * 8 + k));
        f2v_ cf2; cf2.x = cf; cf2.y = cf;
        FP8_AXPY4P(V[k].x, cf2, y2[0], y2[1]);
        FP8_AXPY4P(V[k].y, cf2, y2[2], y2[3]);
        FP8_AXPY4P(V[k].z, cf2, y2[4], y2[5]);
        FP8_AXPY4P(V[k].w, cf2, y2[6], y2[7]);
      }
    }
    }
    {
      float y[16];
#pragma unroll
      for (int i = 0; i < 8; ++i) { y[2 * i] = y2[i].x; y[2 * i + 1] = y2[i].y; }
      float s = 0.f;
#pragma unroll
      for (int i = 0; i < 16; ++i) { y[i] = DN_ALPHA * x[i] + y[i]; s += y[i]; }
      float mu = wsum(s) * (1.f / 1024.f);
      float q = 0.f;
#pragma unroll
      for (int i = 0; i < 16; ++i) { float t = y[i] - mu; q += t * t; }
      float rstd = rsqrtf(wsum(q) * (1.f / 1024.f) + LN_EPS);
#pragma unroll
      for (int i = 0; i < 16; ++i) y[i] = (y[i] - mu) * rstd * g2[e0 + i] + b2[e0 + i];
      float* po = xo + (size_t)tok * 1024 + e0;
      *reinterpret_cast<float4*>(po) = make_float4(y[0], y[1], y[2], y[3]);
      *reinterpret_cast<float4*>(po + 4) = make_float4(y[4], y[5], y[6], y[7]);
      *reinterpret_cast<float4*>(po + 8) = make_float4(y[8], y[9], y[10], y[11]);
      *reinterpret_cast<float4*>(po + 12) = make_float4(y[12], y[13], y[14], y[15]);
      u16* pb = xb + (size_t)tok * 1024 + e0;
      uint4 o0, o1;
      o0.x = pack2(y[0], y[1]); o0.y = pack2(y[2], y[3]); o0.z = pack2(y[4], y[5]); o0.w = pack2(y[6], y[7]);
      o1.x = pack2(y[8], y[9]); o1.y = pack2(y[10], y[11]); o1.z = pack2(y[12], y[13]); o1.w = pack2(y[14], y[15]);
      if (layer == 0) { *reinterpret_cast<uint4*>(pb) = o0; *reinterpret_cast<uint4*>(pb + 8) = o1; }
    }
  }
}

#define XB_TMO      128
#define XB_XCNT(j)  (256  + 64 * (j))
#define XB_XSUB(j)  (1280 + 64 * (j))
#define XB_XGEN(j)  (2304 + 64 * (j))
#define XB_TOP      3328
#define XB_TOPGEN   3392
#define XCD_BAR_WORDS 3456
#define XB_SPIN_CAP (1u << 18)
__device__ __forceinline__ unsigned xb_ld(unsigned* p)              { return __hip_atomic_load(p, __ATOMIC_RELAXED, __HIP_MEMORY_SCOPE_AGENT); }
__device__ __forceinline__ unsigned xb_add(unsigned* p, unsigned v) { return __hip_atomic_fetch_add(p, v, __ATOMIC_RELAXED, __HIP_MEMORY_SCOPE_AGENT); }
__device__ __forceinline__ unsigned xb_xcc_id() { return (unsigned)__builtin_amdgcn_s_getreg((3 << 11) | 20) & 0xFu; }
#define XB_SPIN(cond, bar) do { unsigned _sp = 0; while (cond) { __builtin_amdgcn_s_sleep(1); \
    if ((++_sp & 255u) == 0u) { if (xb_ld(&(bar)[XB_TMO])) break; if (_sp > XB_SPIN_CAP) { atomicAdd(&(bar)[XB_TMO], 1u); break; } } } } while (0)
struct XcdBarrier { unsigned* bar; unsigned x; volatile LAS unsigned* st; };
__device__ __forceinline__ XcdBarrier xcd_barrier_post(unsigned* bar, volatile LAS unsigned* st) {
    XcdBarrier b; b.bar = bar; b.x = xb_xcc_id(); b.st = st;
    if (tidx_() == 0) (void)xb_add(&bar[XB_XCNT(b.x)], 1u);
    return b;
}
__device__ __forceinline__ void xcd_barrier_complete(unsigned* bar, unsigned x, unsigned& nloc, unsigned& nx) {
    const unsigned G = gridDim.x * gridDim.y * gridDim.z;
    unsigned sum, cnt, mine, sp = 0u;
    for (;;) {
        sum = 0u; cnt = 0u; mine = 0u;
#pragma unroll
        for (unsigned j = 0; j < 16; ++j) { const unsigned c = xb_ld(&bar[XB_XCNT(j)]); sum += c; cnt += (c > 0u) ? 1u : 0u; mine = (j == x) ? c : mine; }
        if (sum == G) break;
        __builtin_amdgcn_s_sleep(1);
        if ((++sp & 255u) == 0u) { if (xb_ld(&bar[XB_TMO])) break; if (sp > XB_SPIN_CAP) { atomicAdd(&bar[XB_TMO], 1u); break; } }
    }
    nloc = mine > 0u ? mine : 1u; nx = cnt > 0u ? cnt : 1u;
}
__device__ __forceinline__ void xcd_barrier(const XcdBarrier& b) {
    asm volatile("s_waitcnt vmcnt(0)" ::: "memory");
    __syncthreads();
    if (tidx_() == 0) {
        unsigned* bar = b.bar;
        __builtin_amdgcn_s_waitcnt(0);
        unsigned nloc = b.st[0], nx = b.st[1];
        if (nloc == 0u) { xcd_barrier_complete(bar, b.x, nloc, nx); b.st[0] = nloc; b.st[1] = nx; }
        const unsigned old = xb_add(&bar[XB_XSUB(b.x)], 1u);
        const unsigned gen = old / nloc;
        if (old + 1u == (gen + 1u) * nloc) {
            __builtin_amdgcn_fence(__ATOMIC_RELEASE, "agent");
            asm volatile("s_waitcnt vmcnt(0)" ::: "memory");
            const unsigned og = xb_add(&bar[XB_TOP], 1u);
            const unsigned tg = og / nx;
            if (og + 1u == (tg + 1u) * nx) xb_add(&bar[XB_TOPGEN], 1u);
            else XB_SPIN(xb_ld(&bar[XB_TOPGEN]) == tg, bar);
            __builtin_amdgcn_fence(__ATOMIC_ACQUIRE, "agent");
            xb_add(&bar[XB_XGEN(b.x)], 1u);
            asm volatile("s_waitcnt vmcnt(0)" ::: "memory");
        } else {
            XB_SPIN(xb_ld(&bar[XB_XGEN(b.x)]) == gen, bar);
            __builtin_amdgcn_fence(__ATOMIC_ACQUIRE, "agent");
            asm volatile("s_waitcnt vmcnt(0)" ::: "memory");
        }
    }
    __syncthreads();
}

constexpr int N_PHASES = 16;
__device__ __forceinline__ void run_phase(const Params& p, const int ph, unsigned char* smem) {
  const int bid = blockIdx.x, nb = gridDim.x;
  switch (ph) {
    case 0: phase_prep(p); break;
    case 1: phase_inproj(p, 0, smem); break;
    case 2: for (int it = bid; it < 1024; it += nb) mlstm_A(p, it, smem); break;
    case 3: {
      phase_mlstm_scan(p);
      if (nb == 512) {
        if (bid < 288) { xattn_item(p, 0, bid * 2, smem); xattn_item(p, 0, bid * 2 + 1, smem); }
        else for (int it = 576 + (bid - 288); it < 2048; it += 224) xattn_item(p, 0, it, smem);
      } else {
        for (int it = bid; it < 2048; it += nb) xattn_item(p, 0, it, smem);
      }
    } break;
    case 4: for (int it = bid; it < 2048; it += nb) mlstm_C(p, it, smem); break;
    case 5: phase_outproj(p, 0, smem); break;
    case 6: phase_ln1(p, 0); break;
    case 7: for (int rd = 0; rd < (512 + nb - 1) / nb; ++rd) { int mt, hd; if (xcd_tile(rd, 8, 512, mt, hd)) peer_q_item(p, 0, mt * 8 + hd, smem); } break;
    case 8: phase_peer_experts(p, 0); break;
    case 9: phase_inproj(p, 1, smem); break;
    case 10:
      for (int it = bid; it < 512 + 2048; it += nb) { if (it < 512) rglru_1(p, it, smem); else xattn_item(p, 1, it - 512, smem); }
      break;
    case 11: for (int it = bid; it < 512; it += nb) rglru_2(p, it); break;
    case 12: phase_outproj(p, 1, smem); break;
    case 13: phase_ln1(p, 1); break;
    case 14: for (int rd = 0; rd < (512 + nb - 1) / nb; ++rd) { int mt, hd; if (xcd_tile(rd, 8, 512, mt, hd)) peer_q_item(p, 1, mt * 8 + hd, smem); } break;
    case 15: phase_peer_experts(p, 1); break;
    default: break;
  }
}

template <int PH>
__global__ void __launch_bounds__(256, 2) phase_kernel(Params p) {
  __shared__ __attribute__((aligned(16))) unsigned char smem[SMEM_BYTES];
  run_phase(p, PH, smem);
}

#define SEAM() xcd_barrier(xb)
#ifndef DUP_MASK
#define DUP_MASK 0
#endif
#define RUN(N) do { run_phase(p, N, smem); if (DUP_MASK & (1 << (N))) { SEAM(); run_phase(p, N, smem); } } while (0)
__global__ void __launch_bounds__(256, 2) fwd_megakernel(Params p) {
  __shared__ __attribute__((aligned(16))) unsigned char smem[SMEM_BYTES + 16];
  cg::grid_group grid = cg::this_grid();
  if (tidx_() == 0) *reinterpret_cast<uint4*>(smem + SMEM_BYTES) = make_uint4(0u, 0u, 0u, 0u);
  __syncthreads();
  XcdBarrier xb = xcd_barrier_post((unsigned*)(p.ws + M_BAR), (volatile LAS unsigned*)(smem + SMEM_BYTES));
  if (p.ph_lo < 0) grid.sync();
  run_phase(p, 0, smem); if (DUP_MASK & 1) { SEAM(); run_phase(p, 0, smem); } SEAM();
  RUN(1); SEAM();
  RUN(2); SEAM();
  RUN(3); SEAM();
  RUN(4); SEAM();
  RUN(5); SEAM();
  RUN(6); SEAM();
  RUN(7); SEAM();
  RUN(8); SEAM();
  RUN(9); SEAM();
  RUN(10); SEAM();
  RUN(11); SEAM();
  RUN(12); SEAM();
  RUN(13); SEAM();
  RUN(14); SEAM();
  RUN(15);
}

extern "C" void kernel_launch(void* const* d_in, const int* in_sizes, int n_in, void* d_out, int out_size, void* d_ws, size_t ws_size,
                              hipStream_t stream) {
  if (n_in != 23 || out_size != T_TOK * DM || ws_size < WS_NEED) {
    fprintf(stderr, "kernel_launch: unexpected shapes (n_in %d, out %d, ws %zu); nothing launched\n", n_in, out_size, ws_size);
    return;
  }
  Params p{};
  for (int i = 0; i < 23; ++i) p.in[i] = (const float*)d_in[i];
  p.out = (float*)d_out; p.ws = (unsigned char*)d_ws;
#if MK_COOP
  static int grid_blocks = 0;
  if (!grid_blocks) {
    int dev = 0, cus = 0, per_cu = 0;
    hipGetDevice(&dev);
    hipDeviceGetAttribute(&cus, hipDeviceAttributeMultiprocessorCount, dev);
    hipOccupancyMaxActiveBlocksPerMultiprocessor(&per_cu, fwd_megakernel, 256, 0);
    if (per_cu > 2) per_cu = 2;
    if (per_cu < 1) per_cu = 1;
    grid_blocks = cus * per_cu;
  }
  p.ph_lo = 0; p.ph_hi = N_PHASES;
  hipMemsetAsync((unsigned char*)d_ws + M_BAR, 0, XCD_BAR_WORDS * 4, stream);
  void* args[] = {&p};
  hipError_t e = hipLaunchCooperativeKernel((void*)fwd_megakernel, dim3(grid_blocks), dim3(256), args, 0, stream);
  if (e != hipSuccess) fprintf(stderr, "cooperative launch failed: %s (grid %d)\n", hipGetErrorString(e), grid_blocks);
#else
#define LPH(N) hipLaunchKernelGGL(phase_kernel<N>, dim3(512), dim3(256), 0, stream, p)
  LPH(0); LPH(1); LPH(2); LPH(3); LPH(4); LPH(5); LPH(6); LPH(7);
  LPH(8); LPH(9); LPH(10); LPH(11); LPH(12); LPH(13); LPH(14); LPH(15);
#undef LPH
#endif
}
```

```cpp
#include <hip/hip_runtime.h>
#include <hip/hip_cooperative_groups.h>
#include <cstdio>
#include <cstdint>
namespace cg = cooperative_groups;

#ifndef MK_COOP
#define MK_COOP 1
#endif

#define LAS __attribute__((address_space(3)))
typedef unsigned short u16;
typedef unsigned int u32x4 __attribute__((ext_vector_type(4)));
__device__ __forceinline__ int tidx_() { int t = threadIdx.x; asm volatile("" : "+v"(t)); return t; }
typedef float f32x4v __attribute__((ext_vector_type(4)));
typedef __attribute__((ext_vector_type(8))) short bf16x8;
typedef __attribute__((ext_vector_type(16))) float f32x16;

constexpr int T_TOK = 16384, DM = 1024, SEQ = 4096;
constexpr int ZLD0 = 3328, ZLD1 = 1792;
constexpr float DN_ALPHA = 1.41421356237f;
constexpr float LN_EPS = 1e-5f;
constexpr size_t MiB = 1024 * 1024;

constexpr size_t OFF_TAB  = 0;
constexpr size_t OFF_Z    = 128 * MiB;
constexpr size_t OFF_SCR  = 232 * MiB;
constexpr size_t OFF_XB   = 376 * MiB;
constexpr size_t OFF_CAT  = 408 * MiB;
constexpr size_t OFF_TK   = 440 * MiB;
constexpr size_t OFF_SEL  = 456 * MiB;
constexpr size_t OFF_W    = 472 * MiB;
constexpr size_t OFF_MISC = 500 * MiB;
constexpr size_t WS_NEED  = 508 * MiB;
constexpr size_t W_IN0  = OFF_W;
constexpr size_t W_IN1  = W_IN0 + 7 * MiB;
constexpr size_t W_OUT  = W_IN1 + 4 * MiB;
constexpr size_t W_Q    = W_OUT + 4 * MiB;
constexpr size_t W_KV   = W_Q + 8 * MiB;
constexpr size_t W_MEM  = W_KV + 2 * MiB;
constexpr size_t W_SK   = W_MEM + 2 * MiB;
constexpr size_t W_AF   = W_SK + 128 * 1024;
constexpr size_t M_GATES = OFF_MISC;
constexpr size_t M_STBL  = M_GATES + 512 * 1024;
constexpr size_t M_STML  = M_STBL + 4096;
constexpr size_t M_MIN   = M_STML + 4096;
constexpr size_t M_NLOC  = M_MIN + 4096;
constexpr size_t M_NIN   = M_NLOC + 768 * 1024;
constexpr size_t M_KF    = M_NIN + 768 * 1024;
constexpr size_t M_VF    = M_KF + 1024 * 1024;
constexpr size_t M_SUMP  = M_VF + 1024 * 1024;
constexpr size_t M_SUMH  = M_SUMP + 1536 * 1024;
constexpr size_t M_BAR   = M_SUMH + 1536 * 1024;
constexpr size_t M_TSC   = M_BAR + 16 * 1024;

struct Params {
  const float* in[23];
  float* out;
  unsigned char* ws;
  int ph_lo, ph_hi;
};

constexpr int SMEM_BYTES = 79872;
constexpr int BKP = 72;

typedef float f2cv_ __attribute__((ext_vector_type(2)));
typedef __bf16 bf2cv_ __attribute__((ext_vector_type(2)));
__device__ __forceinline__ u16 f2bf(float f) { __bf16 s = (__bf16)f; return __builtin_bit_cast(u16, s); }
__device__ __forceinline__ float bf2f(u16 h) { return __uint_as_float(((unsigned)h) << 16); }
__device__ __forceinline__ unsigned pack2(float a, float b) { f2cv_ v; v.x = a; v.y = b; bf2cv_ r = __builtin_convertvector(v, bf2cv_); return __builtin_bit_cast(unsigned, r); }
__device__ __forceinline__ float bflo(unsigned w) { return __uint_as_float(w << 16); }
__device__ __forceinline__ float bfhi(unsigned w) { return __uint_as_float(w & 0xffff0000u); }
__device__ __forceinline__ float sigmoidf_(float x) { return 1.f / (1.f + __expf(-x)); }
__device__ __forceinline__ float logsigmoidf_(float x) { return fminf(x, 0.f) - log1pf(expf(-fabsf(x))); }
__device__ __forceinline__ float softplusf_(float x) { return fmaxf(x, 0.f) + log1pf(expf(-fabsf(x))); }
__device__ __forceinline__ float erf_as_(float x) {
  const float ax = fabsf(x);
  const float t = __builtin_amdgcn_rcpf(1.f + 0.3275911f * ax);
  const float poly = t * (0.254829592f + t * (-0.284496736f + t * (1.421413741f + t * (-1.453152027f + t * 1.061405429f))));
  const float r = 1.f - poly * __expf(-ax * ax);
  return copysignf(r, x);
}
__device__ __forceinline__ float geluf_(float x) { return 0.5f * x * (1.f + erf_as_(x * 0.70710678118654752f)); }
__device__ __forceinline__ float wsum(float v) {
#pragma unroll
  for (int o = 32; o > 0; o >>= 1) v += __shfl_xor(v, o);
  return v;
}
__device__ __forceinline__ float wmax(float v) {
#pragma unroll
  for (int o = 32; o > 0; o >>= 1) v = fmaxf(v, __shfl_xor(v, o));
  return v;
}
__device__ __forceinline__ int crow(int reg, int h) { return (reg & 3) + 8 * (reg >> 2) + 4 * h; }
__device__ __forceinline__ f32x16 zero16() {
  f32x16 z;
#pragma unroll
  for (int i = 0; i < 16; ++i) z[i] = 0.f;
  return z;
}
__device__ __forceinline__ bf16x8 ldsfrag(const u16* p) { return *reinterpret_cast<const bf16x8*>(p); }
__device__ __forceinline__ bf16x8 gfrag(const u16* p) { return *reinterpret_cast<const bf16x8*>(p); }
__device__ __forceinline__ bf16x8 ldsfrag_strided(const u16* p, int stride) {
  bf16x8 f;
#pragma unroll
  for (int j = 0; j < 8; ++j) f[j] = (short)p[j * stride];
  return f;
}
__device__ __forceinline__ void ins16(float (&s)[16], float x) {
#pragma unroll
  for (int i = 15; i >= 1; --i) s[i] = __builtin_amdgcn_fmed3f(s[i - 1], s[i], x);
  s[0] = __builtin_amdgcn_fmed3f(__builtin_inff(), s[0], x);
}

__device__ __forceinline__ void gemm_mainloop(const u16* __restrict__ A, const u16* __restrict__ Bt, int m0, int n0,
                                              u16* lds, f32x16 (&acc)[4][2]) {
  const int tid = tidx_(), lane = tid & 63, w = tid >> 6, wm = w >> 1, wn = w & 1, r = lane & 31, h = lane >> 5;
#pragma unroll
  for (int i = 0; i < 4; ++i)
#pragma unroll
    for (int j = 0; j < 2; ++j) acc[i][j] = zero16();
  unsigned char* ldsb = (unsigned char*)lds;
  const int skc = (lane & 3) ^ ((lane >> 4) & 3);
  const u16* Ag = A + (size_t)(m0 + w * 16 + (lane >> 2)) * 1024 + skc * 8;
  const u16* Bg = Bt + (size_t)(n0 + w * 16 + (lane >> 2)) * 1024 + skc * 8;
  const int sw = (r >> 2) & 3;
  const int aoff = (wm * 128 + r) * 64;
  const int boff = 16384 + (wn * 64 + r) * 64;
#define GLDS_STAGE(BUF, KT) do { \
    _Pragma("unroll") \
    for (int i_ = 0; i_ < 4; ++i_) \
      __builtin_amdgcn_global_load_lds((const unsigned*)(Ag + (size_t)i_ * 64 * 1024 + (KT) * 32), (LAS unsigned*)(ldsb + (BUF) * 24576 + (i_ * 4 + w) * 1024), 16, 0, 0); \
    _Pragma("unroll") \
    for (int i_ = 0; i_ < 2; ++i_) \
      __builtin_amdgcn_global_load_lds((const unsigned*)(Bg + (size_t)i_ * 64 * 1024 + (KT) * 32), (LAS unsigned*)(ldsb + (BUF) * 24576 + 16384 + (i_ * 4 + w) * 1024), 16, 0, 0); \
    } while (0)
#define KSTEP(KT, CUR, NXT2, ISSUE) do { \
    if (ISSUE) GLDS_STAGE(NXT2, (KT) + 2); \
    const unsigned char* Bf_ = ldsb + (CUR) * 24576; \
    _Pragma("unroll") \
    for (int kk = 0; kk < 2; ++kk) { \
      const int c_ = ((kk * 2 + h) ^ sw) << 4; \
      bf16x8 b0 = *reinterpret_cast<const bf16x8*>(Bf_ + boff + c_); \
      bf16x8 b1 = *reinterpret_cast<const bf16x8*>(Bf_ + boff + 2048 + c_); \
      _Pragma("unroll") \
      for (int i_ = 0; i_ < 4; ++i_) { \
        bf16x8 a_ = *reinterpret_cast<const bf16x8*>(Bf_ + aoff + i_ * 2048 + c_); \
        acc[i_][0] = __builtin_amdgcn_mfma_f32_32x32x16_bf16(a_, b0, acc[i_][0], 0, 0, 0); \
        acc[i_][1] = __builtin_amdgcn_mfma_f32_32x32x16_bf16(a_, b1, acc[i_][1], 0, 0, 0); \
      } \
    } \
    if (ISSUE) asm volatile("s_waitcnt vmcnt(6)" ::: "memory"); else asm volatile("s_waitcnt vmcnt(0)" ::: "memory"); \
    asm volatile("s_waitcnt lgkmcnt(0)" ::: "memory"); \
    __builtin_amdgcn_s_barrier(); } while (0)
  asm volatile("s_waitcnt vmcnt(0)" ::: "memory");
  __syncthreads();
  GLDS_STAGE(0, 0);
  GLDS_STAGE(1, 1);
  asm volatile("s_waitcnt vmcnt(6)" ::: "memory");
  asm volatile("s_waitcnt lgkmcnt(0)" ::: "memory");
  __builtin_amdgcn_s_barrier();
  int cur = 0, nx2 = 2;
#pragma unroll 1
  for (int kt = 0; kt < 32; ++kt) {
    KSTEP(kt, cur, nx2, (kt + 2 < 32));
    cur = (cur == 2) ? 0 : cur + 1;
    nx2 = (nx2 == 2) ? 0 : nx2 + 1;
  }
#undef KSTEP
#undef GLDS_STAGE
}

__device__ __forceinline__ int xcd_idx(int round) {
  const int b = blockIdx.x, G = gridDim.x;
  if ((G & 511) == 0) return ((round * (G >> 6) + ((b & 7) * (G >> 9)) + ((b >> 3) / 64)) * 64) + ((b >> 3) & 63);
  return round * G + b;
}
__device__ __forceinline__ bool xcd_tile(int round, int NT, int ntiles, int& mt, int& nt) {
  const int b = blockIdx.x, G = gridDim.x;
  int idx;
  if ((G & 511) == 0) { idx = ((round * (G >> 6) + ((b & 7) * (G >> 9)) + ((b >> 3) / 64)) * 64) + ((b >> 3) & 63); }
  else idx = round * G + b;
  if (idx >= ntiles) return false;
  int band = idx / (8 * NT), rem = idx % (8 * NT);
  nt = rem >> 3; mt = band * 8 + (rem & 7);
  return true;
}

__device__ __forceinline__ void cvt8(const float* __restrict__ s, u16* __restrict__ d) {
  float4 a = *reinterpret_cast<const float4*>(s), b = *reinterpret_cast<const float4*>(s + 4);
  uint4 o; o.x = pack2(a.x, a.y); o.y = pack2(a.z, a.w); o.z = pack2(b.x, b.y); o.w = pack2(b.z, b.w);
  *reinterpret_cast<uint4*>(d) = o;
}
__device__ __forceinline__ void transpose_w(const float* __restrict__ W, int N, int Npad, u16* __restrict__ Wt, int srcmap, size_t gtid, size_t gsz) {
  const size_t total = (size_t)Npad * 128;
  for (size_t id = gtid; id < total; id += gsz) {
    int n = (int)(id % Npad), kc = (int)(id / Npad);
    int src = n;
    if (srcmap == 1) { src = (n < 3072) ? n : (n < 3328 ? n + 8 : (n < 3336 ? n - 256 : -1)); }
    else if (n >= N) src = -1;
    float v[8];
#pragma unroll
    for (int j = 0; j < 8; ++j) v[j] = (src >= 0) ? W[(size_t)(kc * 8 + j) * N + src] : 0.f;
    uint4 o; o.x = pack2(v[0], v[1]); o.y = pack2(v[2], v[3]); o.z = pack2(v[4], v[5]); o.w = pack2(v[6], v[7]);
    *reinterpret_cast<uint4*>(Wt + (size_t)n * 1024 + kc * 8) = o;
  }
}
__device__ __forceinline__ void table_piece(const Params& p, int layer, int piece) {
  unsigned char* ws = p.ws;
  unsigned char* tab = ws + OFF_TAB;
  float* tsc = (float*)(ws + M_TSC);
  const int lane = tidx_() & 63, w = tidx_() >> 6;
  f32x4v tv[4][4];
#pragma unroll
  for (int i = 0; i < 4; ++i) {
    const int rr = piece * 16 + w * 4 + i; const int uv = rr >> 14;
    const float* src = (uv ? p.in[20] : p.in[19]) + (size_t)layer * 16384 * 1024 + (size_t)(rr & 16383) * 1024 + lane * 16;
#pragma unroll
    for (int q = 0; q < 4; ++q) tv[i][q] = *reinterpret_cast<const f32x4v*>(src + q * 4);
  }
  __builtin_amdgcn_sched_barrier(0);
#pragma unroll
  for (int i = 0; i < 4; ++i) {
    const int rr = piece * 16 + w * 4 + i;
    const size_t row = (size_t)layer * 32768 + rr;
    const f32x4v a = tv[i][0], b = tv[i][1], c = tv[i][2], d = tv[i][3];
    float m = fmaxf(fmaxf(fmaxf(fabsf(a.x), fabsf(a.y)), fmaxf(fabsf(a.z), fabsf(a.w))), fmaxf(fmaxf(fabsf(b.x), fabsf(b.y)), fmaxf(fabsf(b.z), fabsf(b.w))));
    m = fmaxf(m, fmaxf(fmaxf(fmaxf(fabsf(c.x), fabsf(c.y)), fmaxf(fabsf(c.z), fabsf(c.w))), fmaxf(fmaxf(fabsf(d.x), fabsf(d.y)), fmaxf(fabsf(d.z), fabsf(d.w)))));
    m = wmax(m);
    float sc = (m > 0.f) ? 416.f / m : 1.f;
    u32x4 o;
    int w0 = __builtin_amdgcn_cvt_pk_fp8_f32(a.x * sc, a.y * sc, 0, false); w0 = __builtin_amdgcn_cvt_pk_fp8_f32(a.z * sc, a.w * sc, w0, true);
    int w1 = __builtin_amdgcn_cvt_pk_fp8_f32(b.x * sc, b.y * sc, 0, false); w1 = __builtin_amdgcn_cvt_pk_fp8_f32(b.z * sc, b.w * sc, w1, true);
    int w2 = __builtin_amdgcn_cvt_pk_fp8_f32(c.x * sc, c.y * sc, 0, false); w2 = __builtin_amdgcn_cvt_pk_fp8_f32(c.z * sc, c.w * sc, w2, true);
    int w3 = __builtin_amdgcn_cvt_pk_fp8_f32(d.x * sc, d.y * sc, 0, false); w3 = __builtin_amdgcn_cvt_pk_fp8_f32(d.z * sc, d.w * sc, w3, true);
    o.x = (unsigned)w0; o.y = (unsigned)w1; o.z = (unsigned)w2; o.w = (unsigned)w3;
    *reinterpret_cast<u32x4*>(tab + row * 1024 + lane * 16) = o;
    if (lane == 0) tsc[row] = (m > 0.f) ? m / 416.f : 1.f;
  }
}
__device__ __forceinline__ void phase_prep(const Params& p) {
  const size_t gtid = (size_t)blockIdx.x * 256 + tidx_(), gsz = (size_t)gridDim.x * 256;
  unsigned char* ws = p.ws;
  {
    u16* xb = (u16*)(ws + OFF_XB);
    for (size_t g = gtid; g < (size_t)T_TOK * DM / 8; g += gsz) cvt8(p.in[0] + g * 8, xb + g * 8);
  }
  {
    u16* mb = (u16*)(ws + W_MEM);
    for (size_t g = gtid; g < (size_t)1024 * 1024 / 8; g += gsz) cvt8(p.in[1] + g * 8, mb + g * 8);
  }
  {
    u16* sk = (u16*)(ws + W_SK);
    for (size_t id = gtid; id < (size_t)2 * 2 * 4 * 8 * 64; id += gsz) {
      int lane = (int)(id & 63); int q = (int)(id >> 6);
      int ks = q & 7; q >>= 3; int kt = q & 3; q >>= 2;
      cvt8(p.in[18] + ((size_t)q * 128 + kt * 32 + (lane & 31)) * 128 + ks * 16 + 8 * (lane >> 5), sk + id * 8);
    }
  }
  transpose_w(p.in[2], 3336, 3456, (u16*)(ws + W_IN0), 1, gtid, gsz);
  transpose_w(p.in[5], 1792, 1792, (u16*)(ws + W_IN1), 0, gtid, gsz);
  for (int l = 0; l < 2; ++l) {
    transpose_w(p.in[14] + (size_t)l * 1024 * 1024, 1024, 1024, (u16*)(ws + W_OUT) + (size_t)l * 1024 * 1024, 0, gtid, gsz);
    transpose_w(p.in[17] + (size_t)l * 1024 * 2048, 2048, 2048, (u16*)(ws + W_Q) + (size_t)l * 2048 * 1024, 0, gtid, gsz);
    transpose_w(p.in[13] + (size_t)l * 1024 * 512, 512, 512, (u16*)(ws + W_KV) + (size_t)l * 512 * 1024, 0, gtid, gsz);
  }
  {
    u16* wf = (u16*)(ws + W_AF);
    for (size_t id = gtid; id < (size_t)2 * 8 * 3 * 6 * 64; id += gsz) {
      int lane = (int)(id & 63); int q = (int)(id >> 6);
      int ks = q % 6; q /= 6; int jt = q % 3; q /= 3; int g = q % 8; int mat = q / 8;
      const float* W = mat ? p.in[10] : p.in[8];
      u16 o[8];
#pragma unroll
      for (int j = 0; j < 8; ++j) o[j] = f2bf(W[((size_t)g * 96 + ks * 16 + 8 * (lane >> 5) + j) * 96 + jt * 32 + (lane & 31)]);
      uint4 ov; ov.x = o[0] | (o[1] << 16); ov.y = o[2] | (o[3] << 16); ov.z = o[4] | (o[5] << 16); ov.w = o[6] | (o[7] << 16);
      *reinterpret_cast<uint4*>(wf + id * 8) = ov;
    }
  }
}

__device__ __forceinline__ void epi_store_bf16(const f32x16 (&acc)[4][2], u16* __restrict__ Z, int ld, int m0, int n0, u16* Cs) {
  const int tid = tidx_(), lane = tid & 63, w = tid >> 6, wm = w >> 1, wn = w & 1, r = lane & 31, h = lane >> 5;
#pragma unroll
  for (int i = 0; i < 4; ++i)
#pragma unroll
    for (int j = 0; j < 2; ++j)
#pragma unroll
      for (int reg = 0; reg < 16; ++reg)
        Cs[(wm * 128 + i * 32 + crow(reg, h)) * 136 + wn * 64 + j * 32 + r] = f2bf(acc[i][j][reg]);
  __syncthreads();
#pragma unroll 4
  for (int q = tid; q < 256 * 16; q += 256) {
    int row = q >> 4, cc = q & 15;
    *reinterpret_cast<uint4*>(Z + (size_t)(m0 + row) * ld + n0 + cc * 8) = *reinterpret_cast<const uint4*>(Cs + row * 136 + cc * 8);
  }
}
__device__ __forceinline__ void phase_inproj(const Params& p, int layer, unsigned char* smem) {
  unsigned char* ws = p.ws;
  const u16* xb = (const u16*)(ws + OFF_XB);
  u16* Z = (u16*)(ws + OFF_Z);
  const int NT = layer == 0 ? 27 : 14;
  const int nmain = 64 * NT;
  const int nitems = nmain + (layer == 0 ? 32 : 0);
  const int tid = tidx_(), lane = tid & 63, w = tid >> 6, wm = w >> 1, wn = w & 1, r = lane & 31, h = lane >> 5;
  const int rounds_main = (nmain + gridDim.x - 1) / gridDim.x;
  const int nidle = rounds_main * (int)gridDim.x - nmain;
  const int nkv = nitems - nmain;
  const bool kv_in_idle = nidle >= nkv + 64;
  for (int rd = 0; rd < rounds_main + 1; ++rd) {
    f32x16 acc[4][2];
    int nt = 0, mt = 0, it = 0;
    bool main_tile = false;
    if (rd < rounds_main) {
      main_tile = xcd_tile(rd, NT, nmain, mt, nt);
      if (!main_tile) {
        const int j = xcd_idx(rd) - nmain;
        if (kv_in_idle && j < nkv) it = nmain + j;
        else {
          const int j2 = kv_in_idle ? j - nkv : j, n2 = kv_in_idle ? nidle - nkv : nidle;
          const int pc_lo = layer == 0 ? 0 : 3072, pc_hi = layer == 0 ? 3072 : 4096;
          for (int pc = pc_lo + j2; pc < pc_hi; pc += n2) table_piece(p, pc >> 11, pc & 2047);
          continue;
        }
      }
    }
    else { if (kv_in_idle) continue; it = nmain + blockIdx.x; if (it >= nitems) continue; }
    if (main_tile) {
      const u16* Wt = (const u16*)(ws + (layer == 0 ? W_IN0 : W_IN1));
      gemm_mainloop(xb, Wt, mt * 256, nt * 128, (u16*)smem, acc);
      if (layer == 0 && nt == 26) {
        float* gates = (float*)(ws + M_GATES);
        if (wn == 0 && r < 8) {
#pragma unroll
          for (int i = 0; i < 4; ++i)
#pragma unroll
            for (int reg = 0; reg < 16; ++reg) {
              int row = mt * 256 + wm * 128 + i * 32 + crow(reg, h);
              gates[(size_t)row * 8 + r] = acc[i][0][reg];
            }
        }
      } else {
        epi_store_bf16(acc, Z, layer == 0 ? ZLD0 : ZLD1, mt * 256, nt * 128, (u16*)smem);
      }
    } else {
      int q = it - nmain; int lay = q >> 4; mt = (q >> 2) & 3; nt = q & 3;
      const u16* memb = (const u16*)(ws + W_MEM);
      const u16* Wt = (const u16*)(ws + W_KV) + (size_t)lay * 512 * 1024;
      gemm_mainloop(memb, Wt, mt * 256, nt * 128, (u16*)smem, acc);
      u16* Kf = (u16*)(ws + M_KF) + (size_t)lay * 262144;
      u16* Vf = (u16*)(ws + M_VF) + (size_t)lay * 262144;
#pragma unroll
      for (int i = 0; i < 4; ++i)
#pragma unroll
        for (int j = 0; j < 2; ++j)
#pragma unroll
          for (int reg = 0; reg < 16; ++reg) {
            int row = mt * 256 + wm * 128 + i * 32 + crow(reg, h), col = nt * 128 + wn * 64 + j * 32 + r;
            int b = row >> 8, m = row & 255;
            u16 v = f2bf(acc[i][j][reg]);
            if (col < 256) {
              int head = col >> 6, d = col & 63;
              size_t idx = ((((size_t)(b * 4 + head) * 8 + (m >> 5)) * 4 + (d >> 4)) * 512) + ((((d >> 3) & 1) * 32 + (m & 31)) * 8) + (d & 7);
              Kf[idx] = v;
            } else {
              int c2 = col - 256; int head = c2 >> 6, d = c2 & 63;
              size_t idx = ((((size_t)(b * 4 + head) * 2 + (d >> 5)) * 16 + (m >> 4)) * 512) + ((((m >> 3) & 1) * 32 + (d & 31)) * 8) + (m & 7);
              Vf[idx] = v;
            }
          }
    }
  }
  if (rounds_main * (int)gridDim.x == nmain) {
    const int pc_lo = layer == 0 ? 0 : 3072, pc_hi = layer == 0 ? 3072 : 4096;
    for (int pc2 = pc_lo + (int)blockIdx.x; pc2 < pc_hi; pc2 += (int)gridDim.x) table_piece(p, pc2 >> 11, pc2 & 2047);
  }
}
__device__ __forceinline__ void phase_outproj(const Params& p, int layer, unsigned char* smem) {
  unsigned char* ws = p.ws;
  const u16* cat = (const u16*)(ws + OFF_CAT);
  const u16* Wt = (const u16*)(ws + W_OUT) + (size_t)layer * 1024 * 1024;
  const float* res = layer == 0 ? p.in[0] : p.out;
  float* pre = (float*)(ws + OFF_Z);
  const int tid = tidx_(), lane = tid & 63, w = tid >> 6, wm = w >> 1, wn = w & 1, r = lane & 31, h = lane >> 5;
  for (int rd = 0; rd < (512 + (int)gridDim.x - 1) / (int)gridDim.x; ++rd) {
    int nt, mt;
    if (!xcd_tile(rd, 8, 512, mt, nt)) continue;
    f32x16 acc[4][2];
    gemm_mainloop(cat, Wt, mt * 256, nt * 128, (u16*)smem, acc);
    float* Cs = (float*)smem;
#pragma unroll 1
    for (int hf = 0; hf < 2; ++hf) {
      if (wm == hf) {
#pragma unroll
        for (int i = 0; i < 4; ++i)
#pragma unroll
          for (int j = 0; j < 2; ++j)
#pragma unroll
            for (int reg = 0; reg < 16; ++reg) Cs[(i * 32 + crow(reg, h)) * 132 + wn * 64 + j * 32 + r] = acc[i][j][reg];
      }
      __syncthreads();
#pragma unroll 1
      for (int q0 = tid; q0 < 128 * 32; q0 += 256 * 8) {
        f32x4v rv[8];
#pragma unroll
        for (int u = 0; u < 8; ++u) {
          int q = q0 + u * 256; int row = q >> 5, c4 = q & 31;
          rv[u] = *reinterpret_cast<const f32x4v*>(res + (size_t)(mt * 256 + hf * 128 + row) * 1024 + nt * 128 + c4 * 4);
        }
        __builtin_amdgcn_sched_barrier(0);
#pragma unroll
        for (int u = 0; u < 8; ++u) {
          int q = q0 + u * 256; int row = q >> 5, c4 = q & 31;
          f32x4v cv = *reinterpret_cast<const f32x4v*>(Cs + row * 132 + c4 * 4);
          f32x4v ov; ov.x = DN_ALPHA * rv[u].x + cv.x; ov.y = DN_ALPHA * rv[u].y + cv.y; ov.z = DN_ALPHA * rv[u].z + cv.z; ov.w = DN_ALPHA * rv[u].w + cv.w;
          *reinterpret_cast<f32x4v*>(pre + (size_t)(mt * 256 + hf * 128 + row) * 1024 + nt * 128 + c4 * 4) = ov;
        }
      }
      __syncthreads();
    }
  }
}

__device__ __forceinline__ void phase_ln1(const Params& p, int layer) {
  unsigned char* ws = p.ws;
  const float* pre = (const float*)(ws + OFF_Z);
  u16* xb = (u16*)(ws + OFF_XB);
  const float* g = p.in[15] + layer * 1024; const float* bb = p.in[16] + layer * 1024;
  const int lane = tidx_() & 63, w = tidx_() >> 6;
  f32x4v gg[4], b4[4];
#pragma unroll
  for (int i = 0; i < 4; ++i) { gg[i] = *reinterpret_cast<const f32x4v*>(g + i * 256 + lane * 4); b4[i] = *reinterpret_cast<const f32x4v*>(bb + i * 256 + lane * 4); }
  const int rstride = gridDim.x * 4;
  for (int row0 = blockIdx.x * 4 + w; row0 < T_TOK; row0 += 2 * rstride) {
    const int row1 = row0 + rstride;
    const bool has1 = row1 < T_TOK;
    f32x4v v[2][4];
#pragma unroll
    for (int i = 0; i < 4; ++i) {
      v[0][i] = *reinterpret_cast<const f32x4v*>(pre + (size_t)row0 * 1024 + i * 256 + lane * 4);
      v[1][i] = *reinterpret_cast<const f32x4v*>(pre + (size_t)(has1 ? row1 : row0) * 1024 + i * 256 + lane * 4);
    }
    __builtin_amdgcn_sched_barrier(0);
#pragma unroll
    for (int rr = 0; rr < 2; ++rr) {
      if (rr == 1 && !has1) break;
      const int row = rr ? row1 : row0;
      float s = 0.f;
#pragma unroll
      for (int i = 0; i < 4; ++i) s += v[rr][i].x + v[rr][i].y + v[rr][i].z + v[rr][i].w;
      float mu = wsum(s) * (1.f / 1024.f);
      float q = 0.f;
#pragma unroll
      for (int i = 0; i < 4; ++i) { float a = v[rr][i].x - mu, b = v[rr][i].y - mu, c = v[rr][i].z - mu, d = v[rr][i].w - mu; q += a * a + b * b + c * c + d * d; }
      float rstd = rsqrtf(wsum(q) * (1.f / 1024.f) + LN_EPS);
#pragma unroll
      for (int i = 0; i < 4; ++i) {
        int c0 = i * 256 + lane * 4;
        uint2 o; o.x = pack2((v[rr][i].x - mu) * rstd * gg[i].x + b4[i].x, (v[rr][i].y - mu) * rstd * gg[i].y + b4[i].y);
        o.y = pack2((v[rr][i].z - mu) * rstd * gg[i].z + b4[i].z, (v[rr][i].w - mu) * rstd * gg[i].w + b4[i].w);
        *reinterpret_cast<uint2*>(xb + (size_t)row * 1024 + c0) = o;
      }
    }
  }
}

__device__ __forceinline__ void mlstm_A(const Params& p, int item, unsigned char* smem) {
  unsigned char* ws = p.ws;
  const int tid = tidx_(), lane = tid & 63, w = tid >> 6, r = lane & 31, h2 = lane >> 5;
  const int bh = item >> 6, c = item & 63, b = bh >> 2, hd = bh & 3;
  const int t0 = b * SEQ + c * 64;
  const u16* Z = (const u16*)(ws + OFF_Z);
  const float* gates = (const float*)(ws + M_GATES);
  const float* bg = p.in[3];
  u16* Ks = (u16*)smem; u16* Vs = Ks + 64 * 200; float* wgt = (float*)(Vs + 64 * 200);
  __syncthreads();
  if (tid < 64) {
    float ii = gates[(size_t)(t0 + tid) * 8 + hd] + bg[hd];
    float ff = logsigmoidf_(gates[(size_t)(t0 + tid) * 8 + 4 + hd] + bg[4 + hd]);
    float bc = ff;
#pragma unroll
    for (int o = 1; o < 64; o <<= 1) { float t = __shfl_up(bc, o); if (tid >= o) bc += t; }
    float a = ii - bc;
    float M = wmax(a);
    float bl = __shfl(bc, 63);
    wgt[tid] = expf(a - M);
    if (tid == 0) { ((float*)(ws + M_STBL))[bh * 64 + c] = bl; ((float*)(ws + M_STML))[bh * 64 + c] = bl + M; }
  }
  __syncthreads();
  {
    u32x4 kvr[6], vvr[6];
#pragma unroll
    for (int it = 0; it < 6; ++it) {
      int q = tid + it * 256; int l = q / 24, dc = q % 24;
      const u16* zr = Z + (size_t)(t0 + l) * ZLD0 + hd * 192 + dc * 8;
      kvr[it] = *reinterpret_cast<const u32x4*>(zr + 768);
      vvr[it] = *reinterpret_cast<const u32x4*>(zr + 1536);
    }
    __builtin_amdgcn_sched_barrier(0);
#pragma unroll
    for (int it = 0; it < 6; ++it) {
      int q = tid + it * 256; int l = q / 24, dc = q % 24;
      float sc = wgt[l] * 0.07216878364870322f;
      u32x4 kv = kvr[it], ko;
      ko.x = pack2(bflo(kv.x) * sc, bfhi(kv.x) * sc); ko.y = pack2(bflo(kv.y) * sc, bfhi(kv.y) * sc);
      ko.z = pack2(bflo(kv.z) * sc, bfhi(kv.z) * sc); ko.w = pack2(bflo(kv.w) * sc, bfhi(kv.w) * sc);
      *reinterpret_cast<u32x4*>(Ks + l * 200 + dc * 8) = ko;
      *reinterpret_cast<u32x4*>(Vs + l * 200 + dc * 8) = vvr[it];
    }
  }
  __syncthreads();
  u16* KV = (u16*)(ws + OFF_SCR) + (size_t)(bh * 64 + c) * 36864;
  for (int tt = w; tt < 36; tt += 4) {
    int dt = tt / 6, et = tt % 6;
    f32x16 acc = zero16();
#pragma unroll
    for (int ks = 0; ks < 4; ++ks) {
      bf16x8 a = ldsfrag_strided(Ks + (ks * 16 + 8 * h2) * 200 + dt * 32 + r, 200);
      bf16x8 bb = ldsfrag_strided(Vs + (ks * 16 + 8 * h2) * 200 + et * 32 + r, 200);
      acc = __builtin_amdgcn_mfma_f32_32x32x16_bf16(a, bb, acc, 0, 0, 0);
    }
#pragma unroll
    for (int g = 0; g < 4; ++g) {
      size_t idx = ((size_t)(et * 12 + dt * 2 + (g >> 1)) * 64 + (g & 1) * 32 + r) * 8 + 4 * h2;
      uint2 o; o.x = pack2(acc[g * 4 + 0], acc[g * 4 + 1]); o.y = pack2(acc[g * 4 + 2], acc[g * 4 + 3]);
      *reinterpret_cast<uint2*>(KV + idx) = o;
    }
  }
  if (tid < 192) {
    float s = 0.f;
    for (int l = 0; l < 64; ++l) s += bf2f(Ks[l * 200 + tid]);
    ((float*)(ws + M_NLOC))[(size_t)(bh * 64 + c) * 192 + tid] = s;
  }
}

__device__ __forceinline__ void phase_mlstm_scan(const Params& p) {
  unsigned char* ws = p.ws;
  const size_t gtid = (size_t)blockIdx.x * 256 + tidx_(), gsz = (size_t)gridDim.x * 256;
  const float* stbl = (const float*)(ws + M_STBL); const float* stml = (const float*)(ws + M_STML);
  const u16* KV = (const u16*)(ws + OFF_SCR);
  u16* Cin = (u16*)(ws + OFF_SCR + 72 * MiB);
  for (size_t qid = gtid; qid < (size_t)16 * 4608; qid += gsz) {
    int bh = (int)(qid / 4608), qi = (int)(qid % 4608);
    float C[8], m = 0.f;
#pragma unroll
    for (int i = 0; i < 8; ++i) C[i] = 0.f;
    const size_t ob = (size_t)(bh * 64) * 36864 + (size_t)qi * 8;
    u32x4 nx[8];
#pragma unroll
    for (int j = 0; j < 8; ++j) nx[j] = *reinterpret_cast<const u32x4*>(KV + ob + (size_t)j * 36864);
#pragma unroll 1
    for (int c0 = 0; c0 < 64; c0 += 8) {
      u32x4 cur[8];
#pragma unroll
      for (int j = 0; j < 8; ++j) cur[j] = nx[j];
      if (c0 + 8 < 64) {
#pragma unroll
        for (int j = 0; j < 8; ++j) nx[j] = *reinterpret_cast<const u32x4*>(KV + ob + (size_t)(c0 + 8 + j) * 36864);
      }
      __builtin_amdgcn_sched_barrier(0);
#pragma unroll
      for (int j = 0; j < 8; ++j) {
        const int c = c0 + j;
        float bl = stbl[bh * 64 + c], ml = stml[bh * 64 + c];
        float mn = fmaxf(bl + m, ml);
        float dec = expf(bl + m - mn), wl = expf(ml - mn);
        u32x4 kv = cur[j], co;
        co.x = pack2(C[0], C[1]); co.y = pack2(C[2], C[3]); co.z = pack2(C[4], C[5]); co.w = pack2(C[6], C[7]);
        *reinterpret_cast<u32x4*>(Cin + ob + (size_t)c * 36864) = co;
        C[0] = dec * C[0] + wl * bflo(kv.x); C[1] = dec * C[1] + wl * bfhi(kv.x);
        C[2] = dec * C[2] + wl * bflo(kv.y); C[3] = dec * C[3] + wl * bfhi(kv.y);
        C[4] = dec * C[4] + wl * bflo(kv.z); C[5] = dec * C[5] + wl * bfhi(kv.z);
        C[6] = dec * C[6] + wl * bflo(kv.w); C[7] = dec * C[7] + wl * bfhi(kv.w);
        m = mn;
      }
    }
  }
  const float* nloc = (const float*)(ws + M_NLOC); float* nin = (float*)(ws + M_NIN); float* minp = (float*)(ws + M_MIN);
  const size_t rtid = (size_t)(gridDim.x - 1 - blockIdx.x) * 256 + tidx_();
  for (size_t id = rtid; id < (size_t)16 * 192; id += gsz) {
    int bh = (int)(id / 192), d = (int)(id % 192);
    float n = 0.f, m = 0.f;
#pragma unroll 1
    for (int c0 = 0; c0 < 64; c0 += 16) {
      float nl[16];
#pragma unroll
      for (int j = 0; j < 16; ++j) nl[j] = nloc[(size_t)(bh * 64 + c0 + j) * 192 + d];
      __builtin_amdgcn_sched_barrier(0);
#pragma unroll
      for (int j = 0; j < 16; ++j) {
        const int c = c0 + j;
        float bl = stbl[bh * 64 + c], ml = stml[bh * 64 + c];
        float mn = fmaxf(bl + m, ml);
        float dec = expf(bl + m - mn), wl = expf(ml - mn);
        size_t o = (size_t)(bh * 64 + c) * 192 + d;
        nin[o] = n;
        if (d == 0) minp[bh * 64 + c] = m;
        n = dec * n + wl * nl[j];
        m = mn;
      }
    }
  }
}

__device__ __forceinline__ void mlstm_C(const Params& p, int item, unsigned char* smem) {
  unsigned char* ws = p.ws;
  const int tid = tidx_(), lane = tid & 63, w = tid >> 6, r = lane & 31, h2 = lane >> 5;
  const int bh = item >> 7, c = (item >> 1) & 63, half = item & 1, b = bh >> 2, hd = bh & 3;
  const int t0 = b * SEQ + c * 64, l0 = half * 32;
  const u16* Z = (const u16*)(ws + OFF_Z);
  const float* gates = (const float*)(ws + M_GATES);
  const float* bg = p.in[3];
  u16* Qs = (u16*)smem;
  u16* Ks = Qs + 32 * 200;
  u16* Vs = Ks + 64 * 200;
  float* Ss = (float*)(Vs + 64 * 200);
  u16* Ps = (u16*)(Ss + 32 * 72);
  float* sA = (float*)(Ps + 32 * 72);
  float* sG = sA + 64;
  float* sSc = sG + 64;
  float* sEm = sSc + 64;
  float* sQn = sEm + 64;
  float* sInv = sQn + 32;
  float* sN = sInv + 32;
  float* Hs = (float*)Ks;
  __syncthreads();
  if (tid < 64) {
    float ii = gates[(size_t)(t0 + tid) * 8 + hd] + bg[hd];
    float ff = logsigmoidf_(gates[(size_t)(t0 + tid) * 8 + 4 + hd] + bg[4 + hd]);
    float bc = ff;
#pragma unroll
    for (int o = 1; o < 64; o <<= 1) { float t = __shfl_up(bc, o); if (tid >= o) bc += t; }
    float a = ii - bc;
    float M = a;
#pragma unroll
    for (int o = 1; o < 64; o <<= 1) { float t = __shfl_up(M, o); if (tid >= o) M = fmaxf(M, t); }
    float m_in = ((const float*)(ws + M_MIN))[bh * 64 + c];
    float g = fmaxf(M, m_in);
    sA[tid] = a; sG[tid] = g; sSc[tid] = expf(m_in - g); sEm[tid] = expf(-(bc + g));
  }
  {
    u32x4 kvr[6], vvr[6], qvr[3];
#pragma unroll
    for (int it = 0; it < 6; ++it) {
      int q = tid + it * 256; int l = q / 24, dc = q % 24;
      const u16* zr = Z + (size_t)(t0 + l) * ZLD0 + hd * 192 + dc * 8;
      kvr[it] = *reinterpret_cast<const u32x4*>(zr + 768);
      vvr[it] = *reinterpret_cast<const u32x4*>(zr + 1536);
      if (it < 3) qvr[it] = *reinterpret_cast<const u32x4*>(Z + (size_t)(t0 + l0 + l) * ZLD0 + hd * 192 + dc * 8);
    }
    if (tid < 192) sN[tid] = ((const float*)(ws + M_NIN))[(size_t)(bh * 64 + c) * 192 + tid];
    __builtin_amdgcn_sched_barrier(0);
#pragma unroll
    for (int it = 0; it < 6; ++it) {
      int q = tid + it * 256; int l = q / 24, dc = q % 24;
      const float sc = 0.07216878364870322f;
      u32x4 kv = kvr[it], ko;
      ko.x = pack2(bflo(kv.x) * sc, bfhi(kv.x) * sc); ko.y = pack2(bflo(kv.y) * sc, bfhi(kv.y) * sc);
      ko.z = pack2(bflo(kv.z) * sc, bfhi(kv.z) * sc); ko.w = pack2(bflo(kv.w) * sc, bfhi(kv.w) * sc);
      *reinterpret_cast<u32x4*>(Ks + l * 200 + dc * 8) = ko;
      *reinterpret_cast<u32x4*>(Vs + l * 200 + dc * 8) = vvr[it];
      if (it < 3) *reinterpret_cast<u32x4*>(Qs + l * 200 + dc * 8) = qvr[it];
    }
  }
  __syncthreads();
  if (w < 2) {
    f32x16 acc = zero16();
#pragma unroll
    for (int ks = 0; ks < 12; ++ks) {
      bf16x8 a = ldsfrag(Qs + r * 200 + ks * 16 + h2 * 8);
      bf16x8 bb = ldsfrag(Ks + (w * 32 + r) * 200 + ks * 16 + h2 * 8);
      acc = __builtin_amdgcn_mfma_f32_32x32x16_bf16(a, bb, acc, 0, 0, 0);
    }
#pragma unroll
    for (int reg = 0; reg < 16; ++reg) Ss[crow(reg, h2) * 72 + w * 32 + r] = acc[reg];
  } else {
    int t2 = tid - 128; int l = t2 >> 2, part = t2 & 3;
    float s = 0.f;
    for (int d = part * 48; d < part * 48 + 48; ++d) s += bf2f(Qs[l * 200 + d]) * sN[d];
    s += __shfl_xor(s, 1); s += __shfl_xor(s, 2);
    if (part == 0) sQn[l] = s;
  }
  __syncthreads();
  {
    int l = tid >> 3, sub = tid & 7; int L = l0 + l;
    float gL = sG[L]; float rs = 0.f;
#pragma unroll
    for (int i = 0; i < 8; ++i) {
      int s = sub + 8 * i;
      float pv = 0.f;
      if (s <= L) pv = Ss[l * 72 + s] * expf(sA[s] - gL);
      rs += pv;
      Ps[l * 72 + s] = f2bf(pv);
    }
    rs += __shfl_xor(rs, 1); rs += __shfl_xor(rs, 2); rs += __shfl_xor(rs, 4);
    if (sub == 0) {
      float den = sSc[L] * sQn[l] + rs;
      sInv[l] = 1.f / fmaxf(fabsf(den), sEm[L]);
    }
  }
  __syncthreads();
  const u16* Cin = (const u16*)(ws + OFF_SCR + 72 * MiB) + (size_t)(bh * 64 + c) * 36864;
  for (int et = w; et < 6; et += 4) {
    f32x16 acc = zero16();
    const u16* cf = Cin + (size_t)(et * 12) * 512 + lane * 8;
    bf16x8 cfr[12];
#pragma unroll
    for (int ks = 0; ks < 12; ++ks) cfr[ks] = gfrag(cf + ks * 512);
    __builtin_amdgcn_sched_barrier(0);
#pragma unroll
    for (int ks = 0; ks < 12; ++ks) {
      bf16x8 a = ldsfrag(Qs + r * 200 + ks * 16 + h2 * 8);
      acc = __builtin_amdgcn_mfma_f32_32x32x16_bf16(a, cfr[ks], acc, 0, 0, 0);
    }
#pragma unroll
    for (int reg = 0; reg < 16; ++reg) acc[reg] *= sSc[l0 + crow(reg, h2)];
#pragma unroll
    for (int ks = 0; ks < 4; ++ks) {
      bf16x8 a = ldsfrag(Ps + r * 72 + ks * 16 + h2 * 8);
      bf16x8 bb = ldsfrag_strided(Vs + (ks * 16 + 8 * h2) * 200 + et * 32 + r, 200);
      acc = __builtin_amdgcn_mfma_f32_32x32x16_bf16(a, bb, acc, 0, 0, 0);
    }
#pragma unroll
    for (int reg = 0; reg < 16; ++reg) { int row = crow(reg, h2); Hs[row * 196 + et * 32 + r] = acc[reg] * sInv[row]; }
  }
  __syncthreads();
  {
    int l = tid >> 3, sub = tid & 7;
    float s = 0.f;
    for (int i = 0; i < 24; ++i) s += Hs[l * 196 + sub + 8 * i];
    s += __shfl_xor(s, 1); s += __shfl_xor(s, 2); s += __shfl_xor(s, 4);
    float mu = s * (1.f / 192.f);
    float q = 0.f;
    for (int i = 0; i < 24; ++i) { float d = Hs[l * 196 + sub + 8 * i] - mu; q += d * d; }
    q += __shfl_xor(q, 1); q += __shfl_xor(q, 2); q += __shfl_xor(q, 4);
    float rstd = rsqrtf(q * (1.f / 192.f) + LN_EPS);
    const float* ng = p.in[4] + hd * 192;
    size_t tok = (size_t)(t0 + l0 + l);
    const u16* orow = Z + tok * ZLD0 + 2304 + hd * 192;
    u16* cat = (u16*)(ws + OFF_CAT) + tok * 1024 + hd * 192;
    float ngv[24], ov[24];
#pragma unroll
    for (int i = 0; i < 24; ++i) { ngv[i] = ng[sub + 8 * i]; ov[i] = bf2f(orow[sub + 8 * i]); }
    __builtin_amdgcn_sched_barrier(0);
#pragma unroll
    for (int i = 0; i < 24; ++i) {
      int e = sub + 8 * i;
      float hn = (Hs[l * 196 + e] - mu) * rstd * ngv[i];
      cat[e] = f2bf(hn * sigmoidf_(ov[i]));
    }
  }
}

__device__ __forceinline__ void xattn_item(const Params& p, int layer, int item, unsigned char* smem) {
  unsigned char* ws = p.ws;
  const int tid = tidx_(), lane = tid & 63, w = tid >> 6, r = lane & 31, h2 = lane >> 5;
  const int head = item & 3, tt = item >> 2;
  const int tok0 = tt * 32, b = tok0 / SEQ;
  const u16* Z = (const u16*)(ws + OFF_Z);
  const int zld = layer == 0 ? ZLD0 : ZLD1, xq = layer == 0 ? 3072 : 1536;
  const u16* Kf = (const u16*)(ws + M_KF) + (size_t)layer * 262144 + (size_t)(b * 4 + head) * 8 * 4 * 512;
  const u16* Vf = (const u16*)(ws + M_VF) + (size_t)layer * 262144 + (size_t)(b * 4 + head) * 2 * 16 * 512;
  u16* Qs = (u16*)smem;
  float* Ss = (float*)(Qs + 32 * 72);
  u16* Ps = (u16*)(Ss + 32 * 264);
  float* rinv = (float*)(Ps + 32 * 264);
  __syncthreads();
  bf16x8 kf[8];
#pragma unroll
  for (int i = 0; i < 8; ++i) kf[i] = gfrag(Kf + (size_t)(w * 8 + i) * 512 + lane * 8);
  {
    int l = tid >> 3, cc = tid & 7;
    u32x4 qv = *reinterpret_cast<const u32x4*>(Z + (size_t)(tok0 + l) * zld + xq + head * 64 + cc * 8);
    __builtin_amdgcn_sched_barrier(0);
    *reinterpret_cast<u32x4*>(Qs + l * 72 + cc * 8) = qv;
  }
  __syncthreads();
#pragma unroll
  for (int mm = 0; mm < 2; ++mm) {
    int mt = w * 2 + mm;
    f32x16 acc = zero16();
#pragma unroll
    for (int ks = 0; ks < 4; ++ks) {
      bf16x8 a = ldsfrag(Qs + r * 72 + ks * 16 + h2 * 8);
      acc = __builtin_amdgcn_mfma_f32_32x32x16_bf16(a, kf[mm * 4 + ks], acc, 0, 0, 0);
    }
#pragma unroll
    for (int reg = 0; reg < 16; ++reg) Ss[crow(reg, h2) * 264 + mt * 32 + r] = acc[reg] * 0.125f;
  }
  bf16x8 vf[16];
  if (w < 2) {
#pragma unroll
    for (int ks = 0; ks < 16; ++ks) vf[ks] = gfrag(Vf + (size_t)(w * 16 + ks) * 512 + lane * 8);
  }
  __builtin_amdgcn_sched_barrier(0);
  __syncthreads();
  {
    int l = tid >> 3, sub = tid & 7;
    float mx = -3.0e38f;
    float sv[32];
#pragma unroll
    for (int i = 0; i < 32; ++i) { sv[i] = Ss[l * 264 + sub + 8 * i]; mx = fmaxf(mx, sv[i]); }
    mx = fmaxf(mx, __shfl_xor(mx, 1)); mx = fmaxf(mx, __shfl_xor(mx, 2)); mx = fmaxf(mx, __shfl_xor(mx, 4));
    float s = 0.f;
#pragma unroll
    for (int i = 0; i < 32; ++i) { float e = __expf(sv[i] - mx); Ps[l * 264 + sub + 8 * i] = f2bf(e); s += e; }
    s += __shfl_xor(s, 1); s += __shfl_xor(s, 2); s += __shfl_xor(s, 4);
    if (sub == 0) rinv[l] = 1.f / s;
  }
  __syncthreads();
  if (w < 2) {
    f32x16 acc = zero16();
#pragma unroll
    for (int ks = 0; ks < 16; ++ks) {
      bf16x8 a = ldsfrag(Ps + r * 264 + ks * 16 + h2 * 8);
      acc = __builtin_amdgcn_mfma_f32_32x32x16_bf16(a, vf[ks], acc, 0, 0, 0);
    }
    u16* cat = (u16*)(ws + OFF_CAT);
#pragma unroll
    for (int reg = 0; reg < 16; ++reg) cat[(size_t)(tok0 + crow(reg, h2)) * 1024 + 768 + head * 64 + w * 32 + r] = f2bf(acc[reg] * rinv[crow(reg, h2)]);
  }
}

__device__ __forceinline__ void rglru_1(const Params& p, int item, unsigned char* smem) {
  unsigned char* ws = p.ws;
  const int tid = tidx_(), lane = tid & 63, w = tid >> 6, r = lane & 31, h2 = lane >> 5;
  const int b = item >> 7, c = item & 127;
  const int t0 = b * SEQ + c * 32;
  const u16* Z = (const u16*)(ws + OFF_Z);
  const float* cw = p.in[6]; const float* cb = p.in[7];
  u16* xc = (u16*)smem;
  float* PA = (float*)(ws + OFF_SCR); float* HU = (float*)(ws + OFF_SCR + 48 * MiB);
  __syncthreads();
#pragma unroll 1
  for (int q = tid; q < 32 * 96; q += 256) {
    int l = q / 96, cc = q % 96, ch0 = cc * 8;
    u32x4 xv[4]; f32x4v wlo[4], whi[4];
#pragma unroll
    for (int j = 0; j < 4; ++j) {
      int pp = c * 32 + l - 3 + j; int ppc = pp < 0 ? 0 : pp;
      xv[j] = *reinterpret_cast<const u32x4*>(Z + (size_t)(b * SEQ + ppc) * ZLD1 + 768 + ch0);
      wlo[j] = *reinterpret_cast<const f32x4v*>(cw + j * 768 + ch0); whi[j] = *reinterpret_cast<const f32x4v*>(cw + j * 768 + ch0 + 4);
    }
    float4 c0 = *reinterpret_cast<const float4*>(cb + ch0), c1 = *reinterpret_cast<const float4*>(cb + ch0 + 4);
    __builtin_amdgcn_sched_barrier(0);
    float a[8] = {c0.x, c0.y, c0.z, c0.w, c1.x, c1.y, c1.z, c1.w};
#pragma unroll
    for (int j = 0; j < 4; ++j) {
      const float vm = (c * 32 + l - 3 + j) >= 0 ? 1.f : 0.f;
      a[0] += vm * wlo[j].x * bflo(xv[j].x); a[1] += vm * wlo[j].y * bfhi(xv[j].x); a[2] += vm * wlo[j].z * bflo(xv[j].y); a[3] += vm * wlo[j].w * bfhi(xv[j].y);
      a[4] += vm * whi[j].x * bflo(xv[j].z); a[5] += vm * whi[j].y * bfhi(xv[j].z); a[6] += vm * whi[j].z * bflo(xv[j].w); a[7] += vm * whi[j].w * bfhi(xv[j].w);
    }
    uint4 o; o.x = pack2(a[0], a[1]); o.y = pack2(a[2], a[3]); o.z = pack2(a[4], a[5]); o.w = pack2(a[6], a[7]);
    *reinterpret_cast<uint4*>(xc + l * 776 + ch0) = o;
  }
  __syncthreads();
  const u16* Waf = (const u16*)(ws + W_AF); const u16* Wxf = Waf + 8 * 3 * 6 * 512;
  const float* ba = p.in[9]; const float* bx = p.in[11]; const float* lam = p.in[12];
  float* As_ = (float*)(smem + 49664);
  float* Us_ = As_ + 32 * 97;
  float* sumP = (float*)(ws + M_SUMP); float* sumH = (float*)(ws + M_SUMH);
  bf16x8 b1[6], b2[6];
  if (w < 3) {
#pragma unroll
    for (int ks = 0; ks < 6; ++ks) {
      b1[ks] = gfrag(Waf + (size_t)((0 * 3 + w) * 6 + ks) * 512 + lane * 8);
      b2[ks] = gfrag(Wxf + (size_t)((0 * 3 + w) * 6 + ks) * 512 + lane * 8);
    }
  }
#pragma unroll 1
  for (int g = 0; g < 8; ++g) {
    if (w < 3) {
      const int jt = w;
      f32x16 aa = zero16(), ax = zero16();
#pragma unroll
      for (int ks = 0; ks < 6; ++ks) {
        bf16x8 a = ldsfrag(xc + r * 776 + g * 96 + ks * 16 + h2 * 8);
        aa = __builtin_amdgcn_mfma_f32_32x32x16_bf16(a, b1[ks], aa, 0, 0, 0);
        ax = __builtin_amdgcn_mfma_f32_32x32x16_bf16(a, b2[ks], ax, 0, 0, 0);
      }
      __builtin_amdgcn_sched_barrier(0);
      if (g + 1 < 8) {
#pragma unroll
        for (int ks = 0; ks < 6; ++ks) {
          b1[ks] = gfrag(Waf + (size_t)(((g + 1) * 3 + jt) * 6 + ks) * 512 + lane * 8);
          b2[ks] = gfrag(Wxf + (size_t)(((g + 1) * 3 + jt) * 6 + ks) * 512 + lane * 8);
        }
      }
      __builtin_amdgcn_sched_barrier(0);
      const int chl = jt * 32 + r, ch = g * 96 + chl;
      const float bav = ba[ch], bxv = bx[ch], spl = softplusf_(-lam[ch]);
#pragma unroll
      for (int reg = 0; reg < 16; ++reg) {
        int l = crow(reg, h2);
        float rr = __builtin_amdgcn_rcpf(1.f + __expf(-(aa[reg] + bav))), ig = __builtin_amdgcn_rcpf(1.f + __expf(-(ax[reg] + bxv)));
        float la = -8.f * rr * spl;
        float av = __expf(la);
        float x2 = 2.f * la;
        float om_t = -x2 * (1.f + x2 * 0.5f * (1.f + x2 * (1.f / 3.f) * (1.f + x2 * 0.25f * (1.f + x2 * 0.2f))));
        float om = (x2 > -0.1f) ? om_t : (1.f - av * av);
        As_[l * 97 + chl] = av;
        Us_[l * 97 + chl] = __builtin_amdgcn_sqrtf(om) * ig * bf2f(xc[l * 776 + ch]);
      }
    }
    __syncthreads();
    if (tid < 96) {
      const int ch = g * 96 + tid;
      float P = 1.f, H = 0.f;
#pragma unroll 8
      for (int l = 0; l < 32; ++l) {
        float a = As_[l * 97 + tid], u = Us_[l * 97 + tid];
        H = a * H + u; P *= a;
        size_t o = (size_t)(t0 + l) * 768 + ch;
        PA[o] = P; HU[o] = H;
      }
      sumP[(size_t)(b * 128 + c) * 768 + ch] = P; sumH[(size_t)(b * 128 + c) * 768 + ch] = H;
    }
    __syncthreads();
  }
}
__device__ __forceinline__ void rglru_2(const Params& p, int item) {
  unsigned char* ws = p.ws;
  const int tid = tidx_();
  const int b = item >> 7, c = item & 127;
  const int t0 = b * SEQ + c * 32;
  const u16* Z = (const u16*)(ws + OFF_Z);
  const float* PA = (const float*)(ws + OFF_SCR); const float* HU = (const float*)(ws + OFF_SCR + 48 * MiB);
  const float* sumP = (const float*)(ws + M_SUMP); const float* sumH = (const float*)(ws + M_SUMH);
  u16* cat = (u16*)(ws + OFF_CAT);
  float H[3] = {0.f, 0.f, 0.f};
  for (int c0 = 0; c0 < c; c0 += 8) {
    float sp[3][8], sh[3][8];
#pragma unroll
    for (int k = 0; k < 3; ++k)
#pragma unroll
      for (int j = 0; j < 8; ++j) {
        const int c2 = (c0 + j < c) ? c0 + j : c0;
        const size_t o = (size_t)(b * 128 + c2) * 768 + tid + k * 256;
        sp[k][j] = sumP[o]; sh[k][j] = sumH[o];
      }
    __builtin_amdgcn_sched_barrier(0);
#pragma unroll
    for (int j = 0; j < 8; ++j)
      if (c0 + j < c) {
#pragma unroll
        for (int k = 0; k < 3; ++k) H[k] = sp[k][j] * H[k] + sh[k][j];
      }
  }
#pragma unroll 1
  for (int l0 = 0; l0 < 32; l0 += 8) {
    float hu[3][8], pa[3][8], gt[3][8];
#pragma unroll
    for (int k = 0; k < 3; ++k)
#pragma unroll
      for (int j = 0; j < 8; ++j) {
        const size_t t = (size_t)(t0 + l0 + j); const int ch = tid + k * 256;
        hu[k][j] = HU[t * 768 + ch]; pa[k][j] = PA[t * 768 + ch]; gt[k][j] = bf2f(Z[t * ZLD1 + ch]);
      }
    __builtin_amdgcn_sched_barrier(0);
#pragma unroll
    for (int k = 0; k < 3; ++k)
#pragma unroll
      for (int j = 0; j < 8; ++j) {
        const size_t t = (size_t)(t0 + l0 + j); const int ch = tid + k * 256;
        cat[t * 1024 + ch] = f2bf((hu[k][j] + pa[k][j] * H[k]) * geluf_(gt[k][j]));
      }
  }
}

__device__ __forceinline__ void peer_q_item(const Params& p, int layer, int item, unsigned char* smem) {
  unsigned char* ws = p.ws;
  const int tid = tidx_(), lane = tid & 63, w = tid >> 6, wm = w >> 1, wn = w & 1, r = lane & 31, h2 = lane >> 5;
  const int hd = item & 7, mt = item >> 3;
  const u16* xb = (const u16*)(ws + OFF_XB);
  const u16* Wt = (const u16*)(ws + W_Q) + (size_t)layer * 2048 * 1024;
  const u16* skf = (const u16*)(ws + W_SK) + (size_t)layer * 2 * 16384;
  float* TK = (float*)(ws + OFF_TK);
  u16* Qs = (u16*)smem;
  float* Sf = (float*)smem;
  float* tmp = (float*)(smem + 69632);
#pragma unroll 1
  for (int pp = 0; pp < 2; ++pp) {
    f32x16 acc[4][2];
    gemm_mainloop(xb, Wt, mt * 256, (hd * 2 + pp) * 128, (u16*)smem, acc);
#pragma unroll
    for (int i = 0; i < 4; ++i)
#pragma unroll
      for (int j = 0; j < 2; ++j)
#pragma unroll
        for (int reg = 0; reg < 16; ++reg) Qs[(wm * 128 + i * 32 + crow(reg, h2)) * 136 + wn * 64 + j * 32 + r] = f2bf(acc[i][j][reg]);
    __syncthreads();
#pragma unroll
    for (int i = 0; i < 4; ++i)
#pragma unroll
      for (int j = 0; j < 2; ++j) acc[i][j] = zero16();
    const u16* skp = skf + (size_t)pp * 16384 + (size_t)(wn * 2) * 8 * 512 + lane * 8;
#pragma unroll
    for (int kg = 0; kg < 2; ++kg) {
      bf16x8 b0[4], b1[4];
#pragma unroll
      for (int k4 = 0; k4 < 4; ++k4) { b0[k4] = gfrag(skp + (kg * 4 + k4) * 512); b1[k4] = gfrag(skp + (8 + kg * 4 + k4) * 512); }
      __builtin_amdgcn_sched_barrier(0);
#pragma unroll
      for (int k4 = 0; k4 < 4; ++k4) {
        const int kk = kg * 4 + k4;
#pragma unroll
        for (int i = 0; i < 4; ++i) {
          bf16x8 a = ldsfrag(Qs + (wm * 128 + i * 32 + r) * 136 + kk * 16 + h2 * 8);
          acc[i][0] = __builtin_amdgcn_mfma_f32_32x32x16_bf16(a, b0[k4], acc[i][0], 0, 0, 0);
          acc[i][1] = __builtin_amdgcn_mfma_f32_32x32x16_bf16(a, b1[k4], acc[i][1], 0, 0, 0);
        }
      }
    }
    __syncthreads();
#pragma unroll 1
    for (int hf = 0; hf < 2; ++hf) {
      if (wm == hf) {
#pragma unroll
        for (int i = 0; i < 4; ++i)
#pragma unroll
          for (int j = 0; j < 2; ++j)
#pragma unroll
            for (int reg = 0; reg < 16; ++reg) Sf[(i * 32 + crow(reg, h2)) * 129 + wn * 64 + j * 32 + r] = acc[i][j][reg];
      }
      __syncthreads();
      {
        int row = tid & 127, half = tid >> 7;
        float s[16];
#pragma unroll
        for (int i = 0; i < 16; ++i) s[i] = -3.0e38f;
#pragma unroll 4
        for (int j = 0; j < 64; ++j) {
          int key = half * 64 + j;
          float v = Sf[row * 129 + key];
          v = __uint_as_float((__float_as_uint(v) & ~127u) | (unsigned)key);
          ins16(s, v);
        }
        if (half == 1) {
#pragma unroll
          for (int i = 0; i < 16; ++i) tmp[row * 17 + i] = s[i];
        }
        __syncthreads();
        if (half == 0) {
#pragma unroll
          for (int i = 0; i < 16; ++i) ins16(s, tmp[row * 17 + i]);
          float* dst = TK + ((size_t)(mt * 256 + hf * 128 + row) * 8 + hd) * 32 + pp * 16;
#pragma unroll
          for (int i = 0; i < 4; ++i) *reinterpret_cast<float4*>(dst + i * 4) = make_float4(s[i * 4], s[i * 4 + 1], s[i * 4 + 2], s[i * 4 + 3]);
        }
      }
    }
  }
  __syncthreads();
  {
    const size_t tok = (size_t)mt * 256 + tid;
    const float* tk = TK + (tok * 8 + hd) * 32;
    float f0[16], f1[16], s[16];
#pragma unroll
    for (int i = 0; i < 4; ++i) {
      float4 a = *reinterpret_cast<const float4*>(tk + i * 4), b = *reinterpret_cast<const float4*>(tk + 16 + i * 4);
      f0[i * 4] = a.x; f0[i * 4 + 1] = a.y; f0[i * 4 + 2] = a.z; f0[i * 4 + 3] = a.w;
      f1[i * 4] = b.x; f1[i * 4 + 1] = b.y; f1[i * 4 + 2] = b.z; f1[i * 4 + 3] = b.w;
    }
#pragma unroll
    for (int i = 0; i < 16; ++i) s[i] = -3.0e38f;
#pragma unroll
    for (int i = 0; i < 16; ++i)
#pragma unroll
      for (int j = 0; j < 16; ++j)
        if ((i + 1) * (j + 1) <= 16) {
          float v = f0[i] + f1[j];
          v = __uint_as_float((__float_as_uint(v) & ~255u) | (unsigned)(i * 16 + j));
          ins16(s, v);
        }
    float e[16], sum = 0.f;
#pragma unroll
    for (int k = 0; k < 16; ++k) { e[k] = __expf(s[k] - s[0]); sum += e[k]; }
    float inv = 1.f / sum;
    int* se = (int*)(ws + OFF_SEL) + tok * 128 + hd * 16;
    float* sg = (float*)(ws + OFF_SEL + 8 * MiB) + tok * 128 + hd * 16;
    const unsigned* tku = reinterpret_cast<const unsigned*>(tk);
    unsigned i0v[16], i1v[16];
#pragma unroll
    for (int k = 0; k < 16; ++k) {
      unsigned code = __float_as_uint(s[k]) & 255u;
      i0v[k] = tku[code >> 4]; i1v[k] = tku[16 + (code & 15u)];
    }
    __builtin_amdgcn_sched_barrier(0);
#pragma unroll
    for (int k4 = 0; k4 < 4; ++k4) {
      int4 ev; float4 gv;
      ev.x = (int)((i0v[k4 * 4] & 127u) * 128u + (i1v[k4 * 4] & 127u)); ev.y = (int)((i0v[k4 * 4 + 1] & 127u) * 128u + (i1v[k4 * 4 + 1] & 127u));
      ev.z = (int)((i0v[k4 * 4 + 2] & 127u) * 128u + (i1v[k4 * 4 + 2] & 127u)); ev.w = (int)((i0v[k4 * 4 + 3] & 127u) * 128u + (i1v[k4 * 4 + 3] & 127u));
      gv.x = e[k4 * 4] * inv; gv.y = e[k4 * 4 + 1] * inv; gv.z = e[k4 * 4 + 2] * inv; gv.w = e[k4 * 4 + 3] * inv;
      *reinterpret_cast<int4*>(se + k4 * 4) = ev;
      *reinterpret_cast<float4*>(sg + k4 * 4) = gv;
    }
  }
}

typedef float f2v_ __attribute__((ext_vector_type(2)));
#define FP8_DOT4P(W, XA, XB, ACC2) do { f2v_ lo_ = __builtin_amdgcn_cvt_pk_f32_fp8((int)(W), false); f2v_ hi_ = __builtin_amdgcn_cvt_pk_f32_fp8((int)(W), true); \
    ACC2 = __builtin_elementwise_fma(lo_, XA, ACC2); ACC2 = __builtin_elementwise_fma(hi_, XB, ACC2); } while (0)
#define FP8_AXPY4P(W, CF2, YA, YB) do { f2v_ lo_ = __builtin_amdgcn_cvt_pk_f32_fp8((int)(W), false); f2v_ hi_ = __builtin_amdgcn_cvt_pk_f32_fp8((int)(W), true); \
    YA = __builtin_elementwise_fma(lo_, CF2, YA); YB = __builtin_elementwise_fma(hi_, CF2, YB); } while (0)
__device__ __forceinline__ void phase_peer_experts(const Params& p, int layer) {
  unsigned char* ws = p.ws;
  const int lane = tidx_() & 63, w = tidx_() >> 6;
  const float* pre = (const float*)(ws + OFF_Z);
  const unsigned char* ub = ws + OFF_TAB + (size_t)(layer * 2) * 16384 * 1024;
  const unsigned char* vb = ub + (size_t)16384 * 1024;
  const float* usc = (const float*)(ws + M_TSC) + (size_t)(layer * 2) * 16384;
  const float* vsc = usc + 16384;
  const int* se = (const int*)(ws + OFF_SEL); const float* sg = (const float*)(ws + OFF_SEL + 8 * MiB);
  const float* g1 = p.in[15] + layer * 1024; const float* b1 = p.in[16] + layer * 1024;
  const float* g2 = p.in[21] + layer * 1024; const float* b2 = p.in[22] + layer * 1024;
  u16* xb = (u16*)(ws + OFF_XB);
  float* xo = p.out;
  const int e0 = lane * 16;
  for (int tok = blockIdx.x * 4 + w; tok < T_TOK; tok += gridDim.x * 4) {
    float x[16];
    {
      const float* pr = pre + (size_t)tok * 1024 + e0;
      float4 a = *reinterpret_cast<const float4*>(pr), b = *reinterpret_cast<const float4*>(pr + 4);
      float4 c = *reinterpret_cast<const float4*>(pr + 8), d = *reinterpret_cast<const float4*>(pr + 12);
      x[0] = a.x; x[1] = a.y; x[2] = a.z; x[3] = a.w; x[4] = b.x; x[5] = b.y; x[6] = b.z; x[7] = b.w;
      x[8] = c.x; x[9] = c.y; x[10] = c.z; x[11] = c.w; x[12] = d.x; x[13] = d.y; x[14] = d.z; x[15] = d.w;
      float s = 0.f;
#pragma unroll
      for (int i = 0; i < 16; ++i) s += x[i];
      float mu = wsum(s) * (1.f / 1024.f);
      float q = 0.f;
#pragma unroll
      for (int i = 0; i < 16; ++i) { float t = x[i] - mu; q += t * t; }
      float rstd = rsqrtf(wsum(q) * (1.f / 1024.f) + LN_EPS);
#pragma unroll
      for (int i = 0; i < 16; ++i) x[i] = (x[i] - mu) * rstd * g1[e0 + i] + b1[e0 + i];
    }
    int eA = se[(size_t)tok * 128 + lane], eB = se[(size_t)tok * 128 + 64 + lane];
    float gA = sg[(size_t)tok * 128 + lane], gB = sg[(size_t)tok * 128 + 64 + lane];
    float uA = usc[eA], uB = usc[eB];
    gA *= vsc[eA]; gB *= vsc[eB];
    f2v_ x2[8], y2[8];
#pragma unroll
    for (int i = 0; i < 8; ++i) { x2[i].x = x[2 * i]; x2[i].y = x[2 * i + 1]; y2[i].x = 0.f; y2[i].y = 0.f; }
#pragma unroll 1
    for (int hsel = 0; hsel < 2; ++hsel) {
    const int eS = hsel ? eB : eA; const float gS = hsel ? gB : gA, uS = hsel ? uB : uA;
#pragma unroll 1
    for (int bt = 0; bt < 8; ++bt) {
      uint4 U[8], V[8];
#pragma unroll
      for (int k = 0; k < 8; ++k) {
        int idx = bt * 8 + k;
        int eid = __builtin_amdgcn_readlane(eS, idx);
        U[k] = *reinterpret_cast<const uint4*>(ub + (size_t)eid * 1024 + e0);
        V[k] = *reinterpret_cast<const uint4*>(vb + (size_t)eid * 1024 + e0);
      }
      float w1;
      {
        const bool b0 = (lane & 1) != 0, b1 = (lane & 2) != 0, b2 = (lane & 4) != 0;
        float d8[8];
#pragma unroll
        for (int k = 0; k < 8; ++k) {
          f2v_ d2; d2.x = 0.f; d2.y = 0.f;
          FP8_DOT4P(U[k].x, x2[0], x2[1], d2);
          FP8_DOT4P(U[k].y, x2[2], x2[3], d2);
          FP8_DOT4P(U[k].z, x2[4], x2[5], d2);
          FP8_DOT4P(U[k].w, x2[6], x2[7], d2);
          d8[k] = d2.x + d2.y;
        }
        float w4[4], w2[2];
#pragma unroll
        for (int m = 0; m < 4; ++m) { float keep = b0 ? d8[2 * m + 1] : d8[2 * m], send = b0 ? d8[2 * m] : d8[2 * m + 1]; w4[m] = keep + __shfl_xor(send, 1); }
#pragma unroll
        for (int m = 0; m < 2; ++m) { float keep = b1 ? w4[2 * m + 1] : w4[2 * m], send = b1 ? w4[2 * m] : w4[2 * m + 1]; w2[m] = keep + __shfl_xor(send, 2); }
        { float keep = b2 ? w2[1] : w2[0], send = b2 ? w2[0] : w2[1]; w1 = keep + __shfl_xor(send, 4); }
        w1 += __shfl_xor(w1, 8);
        w1 += __shfl_xor(w1, 16);
        w1 += __shfl_xor(w1, 32);
      }
      const float cfl = gS * geluf_(w1 * uS);
#pragma unroll
      for (int k = 0; k < 8; ++k) {
        float cf = __int_as_float(__builtin_amdgcn_readlane(__float_as_int(cfl), bt * 8 + k));
        f2v_ cf2; cf2.x = cf; cf2.y = cf;
        FP8_AXPY4P(V[k].x, cf2, y2[0], y2[1]);
        FP8_AXPY4P(V[k].y, cf2, y2[2], y2[3]);
        FP8_AXPY4P(V[k].z, cf2, y2[4], y2[5]);
        FP8_AXPY4P(V[k].w, cf2, y2[6], y2[7]);
      }
    }
    }
    {
      float y[16];
#pragma unroll
      for (int i = 0; i < 8; ++i) { y[2 * i] = y2[i].x; y[2 * i + 1] = y2[i].y; }
      float s = 0.f;
#pragma unroll
      for (int i = 0; i < 16; ++i) { y[i] = DN_ALPHA * x[i] + y[i]; s += y[i]; }
      float mu = wsum(s) * (1.f / 1024.f);
      float q = 0.f;
#pragma unroll
      for (int i = 0; i < 16; ++i) { float t = y[i] - mu; q += t * t; }
      float rstd = rsqrtf(wsum(q) * (1.f / 1024.f) + LN_EPS);
#pragma unroll
      for (int i = 0; i < 16; ++i) y[i] = (y[i] - mu) * rstd * g2[e0 + i] + b2[e0 + i];
      float* po = xo + (size_t)tok * 1024 + e0;
      *reinterpret_cast<float4*>(po) = make_float4(y[0], y[1], y[2], y[3]);
      *reinterpret_cast<float4*>(po + 4) = make_float4(y[4], y[5], y[6], y[7]);
      *reinterpret_cast<float4*>(po + 8) = make_float4(y[8], y[9], y[10], y[11]);
      *reinterpret_cast<float4*>(po + 12) = make_float4(y[12], y[13], y[14], y[15]);
      u16* pb = xb + (size_t)tok * 1024 + e0;
      uint4 o0, o1;
      o0.x = pack2(y[0], y[1]); o0.y = pack2(y[2], y[3]); o0.z = pack2(y[4], y[5]); o0.w = pack2(y[6], y[7]);
      o1.x = pack2(y[8], y[9]); o1.y = pack2(y[10], y[11]); o1.z = pack2(y[12], y[13]); o1.w = pack2(y[14], y[15]);
      if (layer == 0) { *reinterpret_cast<uint4*>(pb) = o0; *reinterpret_cast<uint4*>(pb + 8) = o1; }
    }
  }
}

#define XB_TMO      128
#define XB_XCNT(j)  (256  + 64 * (j))
#define XB_XSUB(j)  (1280 + 64 * (j))
#define XB_XGEN(j)  (2304 + 64 * (j))
#define XB_TOP      3328
#define XB_TOPGEN   3392
#define XCD_BAR_WORDS 3456
#define XB_SPIN_CAP (1u << 18)
__device__ __forceinline__ unsigned xb_ld(unsigned* p)              { return __hip_atomic_load(p, __ATOMIC_RELAXED, __HIP_MEMORY_SCOPE_AGENT); }
__device__ __forceinline__ unsigned xb_add(unsigned* p, unsigned v) { return __hip_atomic_fetch_add(p, v, __ATOMIC_RELAXED, __HIP_MEMORY_SCOPE_AGENT); }
__device__ __forceinline__ unsigned xb_xcc_id() { return (unsigned)__builtin_amdgcn_s_getreg((3 << 11) | 20) & 0xFu; }
#define XB_SPIN(cond, bar) do { unsigned _sp = 0; while (cond) { __builtin_amdgcn_s_sleep(2); \
    if ((++_sp & 255u) == 0u) { if (xb_ld(&(bar)[XB_TMO])) break; if (_sp > XB_SPIN_CAP) { atomicAdd(&(bar)[XB_TMO], 1u); break; } } } } while (0)
struct XcdBarrier { unsigned* bar; unsigned x; volatile LAS unsigned* st; };
__device__ __forceinline__ XcdBarrier xcd_barrier_post(unsigned* bar, volatile LAS unsigned* st) {
    XcdBarrier b; b.bar = bar; b.x = xb_xcc_id(); b.st = st;
    if (tidx_() == 0) (void)xb_add(&bar[XB_XCNT(b.x)], 1u);
    return b;
}
__device__ __forceinline__ void xcd_barrier_complete(unsigned* bar, unsigned x, unsigned& nloc, unsigned& nx) {
    const unsigned G = gridDim.x * gridDim.y * gridDim.z;
    unsigned sum, cnt, mine, sp = 0u;
    for (;;) {
        sum = 0u; cnt = 0u; mine = 0u;
#pragma unroll
        for (unsigned j = 0; j < 16; ++j) { const unsigned c = xb_ld(&bar[XB_XCNT(j)]); sum += c; cnt += (c > 0u) ? 1u : 0u; mine = (j == x) ? c : mine; }
        if (sum == G) break;
        __builtin_amdgcn_s_sleep(1);
        if ((++sp & 255u) == 0u) { if (xb_ld(&bar[XB_TMO])) break; if (sp > XB_SPIN_CAP) { atomicAdd(&bar[XB_TMO], 1u); break; } }
    }
    nloc = mine > 0u ? mine : 1u; nx = cnt > 0u ? cnt : 1u;
}
__device__ __forceinline__ void xcd_barrier(const XcdBarrier& b) {
    asm volatile("s_waitcnt vmcnt(0)" ::: "memory");
    __syncthreads();
    if (tidx_() == 0) {
        unsigned* bar = b.bar;
        __builtin_amdgcn_s_waitcnt(0);
        unsigned nloc = b.st[0], nx = b.st[1];
        if (nloc == 0u) { xcd_barrier_complete(bar, b.x, nloc, nx); b.st[0] = nloc; b.st[1] = nx; }
        const unsigned old = xb_add(&bar[XB_XSUB(b.x)], 1u);
        const unsigned gen = old / nloc;
        if (old + 1u == (gen + 1u) * nloc) {
            __builtin_amdgcn_fence(__ATOMIC_RELEASE, "agent");
            asm volatile("s_waitcnt vmcnt(0)" ::: "memory");
            const unsigned og = xb_add(&bar[XB_TOP], 1u);
            const unsigned tg = og / nx;
            if (og + 1u == (tg + 1u) * nx) xb_add(&bar[XB_TOPGEN], 1u);
            else XB_SPIN(xb_ld(&bar[XB_TOPGEN]) == tg, bar);
            __builtin_amdgcn_fence(__ATOMIC_ACQUIRE, "agent");
            xb_add(&bar[XB_XGEN(b.x)], 1u);
            asm volatile("s_waitcnt vmcnt(0)" ::: "memory");
        } else {
            XB_SPIN(xb_ld(&bar[XB_XGEN(b.x)]) == gen, bar);
            __builtin_amdgcn_fence(__ATOMIC_ACQUIRE, "agent");
            asm volatile("s_waitcnt vmcnt(0)" ::: "memory");
        }
    }
    __syncthreads();
}

constexpr int N_PHASES = 16;
__device__ __forceinline__ void run_phase(const Params& p, const int ph, unsigned char* smem) {
  const int bid = blockIdx.x, nb = gridDim.x;
  switch (ph) {
    case 0: phase_prep(p); break;
    case 1: phase_inproj(p, 0, smem); break;
    case 2: for (int it = bid; it < 1024; it += nb) mlstm_A(p, it, smem); break;
    case 3: {
      phase_mlstm_scan(p);
      if (nb == 512) {
        if (bid < 288) { xattn_item(p, 0, bid * 2, smem); xattn_item(p, 0, bid * 2 + 1, smem); }
        else for (int it = 576 + (bid - 288); it < 2048; it += 224) xattn_item(p, 0, it, smem);
      } else {
        for (int it = bid; it < 2048; it += nb) xattn_item(p, 0, it, smem);
      }
    } break;
    case 4: for (int it = bid; it < 2048; it += nb) mlstm_C(p, it, smem); break;
    case 5: phase_outproj(p, 0, smem); break;
    case 6: phase_ln1(p, 0); break;
    case 7: for (int rd = 0; rd < (512 + nb - 1) / nb; ++rd) { int mt, hd; if (xcd_tile(rd, 8, 512, mt, hd)) peer_q_item(p, 0, mt * 8 + hd, smem); } break;
    case 8: phase_peer_experts(p, 0); break;
    case 9: phase_inproj(p, 1, smem); break;
    case 10:
      for (int it = bid; it < 512 + 2048; it += nb) { if (it < 512) rglru_1(p, it, smem); else xattn_item(p, 1, it - 512, smem); }
      break;
    case 11: for (int it = bid; it < 512; it += nb) rglru_2(p, it); break;
    case 12: phase_outproj(p, 1, smem); break;
    case 13: phase_ln1(p, 1); break;
    case 14: for (int rd = 0; rd < (512 + nb - 1) / nb; ++rd) { int mt, hd; if (xcd_tile(rd, 8, 512, mt, hd)) peer_q_item(p, 1, mt * 8 + hd, smem); } break;
    case 15: phase_peer_experts(p, 1); break;
    default: break;
  }
}

template <int PH>
__global__ void __launch_bounds__(256, 2) phase_kernel(Params p) {
  __shared__ __attribute__((aligned(16))) unsigned char smem[SMEM_BYTES];
  run_phase(p, PH, smem);
}

#define SEAM() xcd_barrier(xb)
#ifndef DUP_MASK
#define DUP_MASK 0
#endif
#define RUN(N) do { run_phase(p, N, smem); if (DUP_MASK & (1 << (N))) { SEAM(); run_phase(p, N, smem); } } while (0)
__global__ void __launch_bounds__(256, 2) fwd_megakernel(Params p) {
  __shared__ __attribute__((aligned(16))) unsigned char smem[SMEM_BYTES + 16];
  cg::grid_group grid = cg::this_grid();
  if (tidx_() == 0) *reinterpret_cast<uint4*>(smem + SMEM_BYTES) = make_uint4(0u, 0u, 0u, 0u);
  __syncthreads();
  XcdBarrier xb = xcd_barrier_post((unsigned*)(p.ws + M_BAR), (volatile LAS unsigned*)(smem + SMEM_BYTES));
  if (p.ph_lo < 0) grid.sync();
  run_phase(p, 0, smem); if (DUP_MASK & 1) { SEAM(); run_phase(p, 0, smem); } SEAM();
  RUN(1); SEAM();
  RUN(2); SEAM();
  RUN(3); SEAM();
  RUN(4); SEAM();
  RUN(5); SEAM();
  RUN(6); SEAM();
  RUN(7); SEAM();
  RUN(8); SEAM();
  RUN(9); SEAM();
  RUN(10); SEAM();
  RUN(11); SEAM();
  RUN(12); SEAM();
  RUN(13); SEAM();
  RUN(14); SEAM();
  RUN(15);
}

extern "C" void kernel_launch(void* const* d_in, const int* in_sizes, int n_in, void* d_out, int out_size, void* d_ws, size_t ws_size,
                              hipStream_t stream) {
  if (n_in != 23 || out_size != T_TOK * DM || ws_size < WS_NEED) {
    fprintf(stderr, "kernel_launch: unexpected shapes (n_in %d, out %d, ws %zu); nothing launched\n", n_in, out_size, ws_size);
    return;
  }
  Params p{};
  for (int i = 0; i < 23; ++i) p.in[i] = (const float*)d_in[i];
  p.out = (float*)d_out; p.ws = (unsigned char*)d_ws;
#if MK_COOP
  static int grid_blocks = 0;
  if (!grid_blocks) {
    int dev = 0, cus = 0, per_cu = 0;
    hipGetDevice(&dev);
    hipDeviceGetAttribute(&cus, hipDeviceAttributeMultiprocessorCount, dev);
    hipOccupancyMaxActiveBlocksPerMultiprocessor(&per_cu, fwd_megakernel, 256, 0);
    if (per_cu > 2) per_cu = 2;
    if (per_cu < 1) per_cu = 1;
    grid_blocks = cus * per_cu;
  }
  p.ph_lo = 0; p.ph_hi = N_PHASES;
  hipMemsetAsync((unsigned char*)d_ws + M_BAR, 0, XCD_BAR_WORDS * 4, stream);
  void* args[] = {&p};
  hipError_t e = hipLaunchCooperativeKernel((void*)fwd_megakernel, dim3(grid_blocks), dim3(256), args, 0, stream);
  if (e != hipSuccess) fprintf(stderr, "cooperative launch failed: %s (grid %d)\n", hipGetErrorString(e), grid_blocks);
#else
#define LPH(N) hipLaunchKernelGGL(phase_kernel<N>, dim3(512), dim3(256), 0, stream, p)
  LPH(0); LPH(1); LPH(2); LPH(3); LPH(4); LPH(5); LPH(6); LPH(7);
  LPH(8); LPH(9); LPH(10); LPH(11); LPH(12); LPH(13); LPH(14); LPH(15);
#undef LPH
#endif
}
```
